# Optimizing an MI355X kernel written in HIP

```python
import math
import jax
import jax.numpy as jnp
from jax import lax
import numpy as np

D_MODEL = 1024
BATCH = 8
SEQ = 4096
DEPTH = 2

D_FF = 2816
MLA_HEADS = 4
MLA_NOPE_DIM = 64
MLA_ROPE_DIM = 32
MLA_V_DIM = 64
MLA_Q_LORA = 256
MLA_KV_LORA = 128
DIFF_HEADS = 4
DIFF_QK_DIM = 32
DIFF_V_DIM = 64
NSA_HEADS = 8
NSA_GROUPS = 2
NSA_DK = 64
NSA_DV = 64
CMP_BLOCK = 32
CMP_STRIDE = 16
CMP_HIDDEN = 256
SEL_BLOCK = 64
SEL_TOPK = 16
WINDOW = 512
NSA_Q_BLOCK = 64
ATTN_Q_BLOCK = 128
ROPE_THETA = 10000.0
EPS = 1e-6
NEG = -1e30
FORCE = 1e4

D_MIX = MLA_HEADS * MLA_V_DIM + DIFF_HEADS * DIFF_V_DIM + NSA_HEADS * NSA_DV
IN_SPLITS = (
    MLA_Q_LORA,
    MLA_KV_LORA,
    MLA_ROPE_DIM,
    DIFF_HEADS * 2 * DIFF_QK_DIM,
    DIFF_HEADS * 2 * DIFF_QK_DIM,
    DIFF_HEADS * DIFF_V_DIM,
    NSA_HEADS * NSA_DK,
    3 * 2 * NSA_GROUPS * NSA_DK,
    NSA_HEADS * 3,
)
N_IN = sum(IN_SPLITS)

kernel_name = 'hymba_mla_diff_nsa_macaron'


def rms_norm(x, g):
    xf = x.astype(jnp.float32)
    y = xf * lax.rsqrt(jnp.mean(xf * xf, axis=-1, keepdims=True) + EPS)
    return (y * g.astype(jnp.float32)).astype(x.dtype)


def rope_tables(seq, dim):
    inv = ROPE_THETA ** (-jnp.arange(0, dim, 2, dtype=jnp.float32) / dim)
    ang = jnp.arange(seq, dtype=jnp.float32)[:, None] * inv[None, :]
    return jnp.cos(ang), jnp.sin(ang)


def apply_rope(x, cos, sin):
    half = x.shape[-1] // 2
    x1, x2 = x[..., :half], x[..., half:]
    c = cos[None, :, None, :].astype(x.dtype)
    s = sin[None, :, None, :].astype(x.dtype)
    return jnp.concatenate([x1 * c - x2 * s, x2 * c + x1 * s], axis=-1)


def swiglu(h, wg, wu, wd):
    return (jax.nn.silu(h @ wg) * (h @ wu)) @ wd


def to_blocks(a, nb, qb):
    return a.reshape((a.shape[0], nb, qb) + a.shape[2:]).swapaxes(0, 1)


def from_blocks(a):
    nb, b, qb = a.shape[:3]
    return a.swapaxes(0, 1).reshape((b, nb * qb) + a.shape[3:])


def mla_attention(q_nope, q_rope, k_nope, k_rope, v):
    t = q_nope.shape[1]
    nb = t // ATTN_Q_BLOCK
    kpos = jnp.arange(t)
    scale = (MLA_NOPE_DIM + MLA_ROPE_DIM) ** -0.5

    def block(args):
        qn, qr, bi = args
        qpos = bi * ATTN_Q_BLOCK + jnp.arange(ATTN_Q_BLOCK)
        s = (jnp.einsum('bqhd,bkhd->bhqk', qn, k_nope)
             + jnp.einsum('bqhr,bkr->bhqk', qr, k_rope)).astype(jnp.float32) * scale
        s = jnp.where(kpos[None, :] <= qpos[:, None], s, NEG)
        p = jax.nn.softmax(s, axis=-1).astype(v.dtype)
        return jnp.einsum('bhqk,bkhd->bqhd', p, v)

    out = lax.map(block, (to_blocks(q_nope, nb, ATTN_Q_BLOCK),
                          to_blocks(q_rope, nb, ATTN_Q_BLOCK), jnp.arange(nb)))
    return from_blocks(out)


def diff_attention(q, k, v, lam):
    t = q.shape[1]
    nb = t // ATTN_Q_BLOCK
    kpos = jnp.arange(t)
    scale = DIFF_QK_DIM ** -0.5

    def block(args):
        qb, bi = args
        qpos = bi * ATTN_Q_BLOCK + jnp.arange(ATTN_Q_BLOCK)
        s = jnp.einsum('bqhmd,bkhmd->bhmqk', qb, k).astype(jnp.float32) * scale
        s = jnp.where(kpos[None, :] <= qpos[:, None], s, NEG)
        p = jax.nn.softmax(s, axis=-1)
        a = p[:, :, 0] - lam * p[:, :, 1]
        return jnp.einsum('bhqk,bkhd->bqhd', a.astype(v.dtype), v)

    out = lax.map(block, (to_blocks(q, nb, ATTN_Q_BLOCK), jnp.arange(nb)))
    return from_blocks(out)


def compress_tokens(tok, pos_emb, w1, b1, w2):
    b, t, g, d = tok.shape
    nc = (t - CMP_BLOCK) // CMP_STRIDE + 1
    idx = np.arange(nc)[:, None] * CMP_STRIDE + np.arange(CMP_BLOCK)[None, :]
    blk = tok[:, idx] + pos_emb[None, None, :, None, :]
    flat = blk.transpose(0, 1, 3, 2, 4).reshape(b, nc, g, CMP_BLOCK * d)
    return jax.nn.silu(flat @ w1 + b1) @ w2


def nsa_attention(q, k_cmp, v_cmp, k_slc, v_slc, k_win, v_win, gates):
    b, t, h, dk = q.shape
    g = NSA_GROUPS
    hg = h // g
    dv = v_slc.shape[-1]
    nc = k_cmp.shape[1]
    nb_sel = t // SEL_BLOCK
    n_sel = min(SEL_TOPK, nb_sel)
    qn = NSA_Q_BLOCK
    nq = t // qn
    scale = dk ** -0.5
    cmp_end = jnp.arange(nc) * CMP_STRIDE + CMP_BLOCK - 1
    r_sel = SEL_BLOCK // CMP_STRIDE
    r_cmp = CMP_BLOCK // CMP_STRIDE
    map_idx = (np.arange(nb_sel)[:, None, None] * r_sel
               - np.arange(r_sel)[None, :, None]
               - np.arange(r_cmp)[None, None, :]).reshape(nb_sel, -1)
    map_valid = (map_idx >= 0) & (map_idx < nc)
    map_idx = np.clip(map_idx, 0, nc - 1)
    k_blk = k_slc.reshape(b, nb_sel, SEL_BLOCK, g, dk).transpose(0, 3, 1, 2, 4)
    v_blk = v_slc.reshape(b, nb_sel, SEL_BLOCK, g, dv).transpose(0, 3, 1, 2, 4)
    k_wp = jnp.pad(k_win, ((0, 0), (WINDOW, 0), (0, 0), (0, 0)))
    v_wp = jnp.pad(v_win, ((0, 0), (WINDOW, 0), (0, 0), (0, 0)))
    bi = jnp.arange(b)[:, None, None, None]
    gi = jnp.arange(g)[None, :, None, None]
    blk_ids = jnp.arange(nb_sel)
    tok_in_blk = jnp.arange(SEL_BLOCK)
    win_off = jnp.arange(qn + WINDOW)

    def chunk(args):
        qc, gc, ci = args
        qg = qc.reshape(b, qn, g, hg, dk)
        tpos = ci * qn + jnp.arange(qn)
        s = jnp.einsum('bqghd,bngd->bghqn', qg, k_cmp).astype(jnp.float32) * scale
        valid = cmp_end[None, :] <= tpos[:, None]
        p_c = jax.nn.softmax(jnp.where(valid, s, NEG), axis=-1) * valid
        o_cmp = jnp.einsum('bghqn,bngd->bqghd', p_c.astype(v_cmp.dtype), v_cmp)
        pg = p_c.sum(axis=2)
        p_slc = jnp.where(map_valid, pg[..., map_idx], 0.0).sum(-1)
        cblk = (tpos // SEL_BLOCK)[:, None]
        forced = (blk_ids == 0) | (blk_ids == cblk) | (blk_ids == cblk - 1)
        score = jnp.where(blk_ids > cblk, -1.0, p_slc + jnp.where(forced, FORCE, 0.0))
        _, sel = lax.top_k(score, n_sel)
        k_sel = k_blk[bi, gi, sel]
        v_sel = v_blk[bi, gi, sel]
        kpos = sel[..., None] * SEL_BLOCK + tok_in_blk
        m_s = (kpos <= tpos[None, None, :, None, None])[:, :, None]
        s = jnp.einsum('bqghd,bgqnkd->bghqnk', qg, k_sel).astype(jnp.float32) * scale
        p_s = jax.nn.softmax(jnp.where(m_s, s, NEG), axis=(-2, -1))
        o_slc = jnp.einsum('bghqnk,bgqnkd->bqghd', p_s.astype(v_sel.dtype), v_sel)
        k_w = lax.dynamic_slice_in_dim(k_wp, ci * qn, qn + WINDOW, axis=1)
        v_w = lax.dynamic_slice_in_dim(v_wp, ci * qn, qn + WINDOW, axis=1)
        kpos_w = ci * qn - WINDOW + win_off
        delta = tpos[:, None] - kpos_w[None, :]
        m_w = (delta >= 0) & (delta < WINDOW) & (kpos_w >= 0)[None, :]
        s = jnp.einsum('bqghd,bkgd->bghqk', qg, k_w).astype(jnp.float32) * scale
        p_w = jax.nn.softmax(jnp.where(m_w, s, NEG), axis=-1)
        o_win = jnp.einsum('bghqk,bkgd->bqghd', p_w.astype(v_w.dtype), v_w)
        gt = gc.reshape(b, qn, g, hg, 3)
        o = gt[..., 0:1] * o_cmp + gt[..., 1:2] * o_slc + gt[..., 2:3] * o_win
        return o.reshape(b, qn, h, dv)

    out = lax.map(chunk, (to_blocks(q, nq, qn), to_blocks(gates, nq, qn), jnp.arange(nq)))
    return from_blocks(out)


def token_mixer(h, w_in, mla_q_norm_g, mla_w_uq, mla_kv_norm_g, mla_w_ukv,
                diff_lambda, diff_norm_g, lam_init,
                cmp_pos, cmp_w1, cmp_b1, cmp_w2, gate_b, w_out,
                cs_mla, cs_diff, cs_nsa):
    b, t, _ = h.shape
    splits = np.cumsum(IN_SPLITS)[:-1].tolist()
    cq, ckv, kr, dq, dkk, dvv, nq, nkv, ng = jnp.split(h @ w_in, splits, axis=-1)

    qm = (rms_norm(cq, mla_q_norm_g) @ mla_w_uq).reshape(b, t, MLA_HEADS, MLA_NOPE_DIM + MLA_ROPE_DIM)
    q_nope = qm[..., :MLA_NOPE_DIM]
    q_rope = apply_rope(qm[..., MLA_NOPE_DIM:], *cs_mla)
    kvm = (rms_norm(ckv, mla_kv_norm_g) @ mla_w_ukv).reshape(b, t, MLA_HEADS, MLA_NOPE_DIM + MLA_V_DIM)
    k_nope = kvm[..., :MLA_NOPE_DIM]
    v_mla = kvm[..., MLA_NOPE_DIM:]
    k_rope = apply_rope(kr[:, :, None, :], *cs_mla)[:, :, 0, :]
    o_mla = mla_attention(q_nope, q_rope, k_nope, k_rope, v_mla)

    qd = apply_rope(dq.reshape(b, t, DIFF_HEADS * 2, DIFF_QK_DIM), *cs_diff).reshape(b, t, DIFF_HEADS, 2, DIFF_QK_DIM)
    kd = apply_rope(dkk.reshape(b, t, DIFF_HEADS * 2, DIFF_QK_DIM), *cs_diff).reshape(b, t, DIFF_HEADS, 2, DIFF_QK_DIM)
    vd = dvv.reshape(b, t, DIFF_HEADS, DIFF_V_DIM)
    lf = diff_lambda.astype(jnp.float32)
    lam = jnp.exp(jnp.sum(lf[0] * lf[1])) - jnp.exp(jnp.sum(lf[2] * lf[3])) + lam_init
    o_diff = rms_norm(diff_attention(qd, kd, vd, lam), diff_norm_g) * (1.0 - lam_init)

    qn_ = apply_rope(nq.reshape(b, t, NSA_HEADS, NSA_DK), *cs_nsa)
    kv = nkv.reshape(b, t, 3, 2, NSA_GROUPS, NSA_DK)
    k_all = apply_rope(kv[:, :, :, 0].reshape(b, t, 3 * NSA_GROUPS, NSA_DK), *cs_nsa).reshape(b, t, 3, NSA_GROUPS, NSA_DK)
    v_all = kv[:, :, :, 1]
    k_cmp = compress_tokens(k_all[:, :, 0], cmp_pos[0], cmp_w1[0], cmp_b1[0], cmp_w2[0])
    v_cmp = compress_tokens(v_all[:, :, 0], cmp_pos[1], cmp_w1[1], cmp_b1[1], cmp_w2[1])
    gates = jax.nn.sigmoid(ng + gate_b).reshape(b, t, NSA_HEADS, 3)
    o_nsa = nsa_attention(qn_, k_cmp, v_cmp, k_all[:, :, 1], v_all[:, :, 1],
                          k_all[:, :, 2], v_all[:, :, 2], gates)

    o = jnp.concatenate([o_mla.reshape(b, t, -1), o_diff.reshape(b, t, -1),
                         o_nsa.reshape(b, t, -1)], axis=-1)
    return o @ w_out


def setup_inputs(seed: int = 0) -> dict:
    key = jax.random.key(seed)
    ks = jax.random.split(key, 24)

    def nrm(k, shape, scale):
        return jax.random.normal(k, shape, jnp.float32) * scale

    def gain(k, shape):
        return 1.0 + 0.02 * jax.random.normal(k, shape, jnp.float32)

    return {
        'x': nrm(ks[0], (BATCH, SEQ, D_MODEL), 1.0),
        'ffn_norm_g': gain(ks[1], (DEPTH, 2, D_MODEL)),
        'ffn_w_gate': nrm(ks[2], (DEPTH, 2, D_MODEL, D_FF), D_MODEL ** -0.5),
        'ffn_w_up': nrm(ks[3], (DEPTH, 2, D_MODEL, D_FF), D_MODEL ** -0.5),
        'ffn_w_down': nrm(ks[4], (DEPTH, 2, D_FF, D_MODEL), D_FF ** -0.5),
        'mix_norm_g': gain(ks[5], (DEPTH, D_MODEL)),
        'w_in': nrm(ks[6], (DEPTH, D_MODEL, N_IN), D_MODEL ** -0.5),
        'mla_q_norm_g': gain(ks[7], (DEPTH, MLA_Q_LORA)),
        'mla_w_uq': nrm(ks[8], (DEPTH, MLA_Q_LORA, MLA_HEADS * (MLA_NOPE_DIM + MLA_ROPE_DIM)), MLA_Q_LORA ** -0.5),
        'mla_kv_norm_g': gain(ks[9], (DEPTH, MLA_KV_LORA)),
        'mla_w_ukv': nrm(ks[10], (DEPTH, MLA_KV_LORA, MLA_HEADS * (MLA_NOPE_DIM + MLA_V_DIM)), MLA_KV_LORA ** -0.5),
        'diff_lambda': nrm(ks[11], (DEPTH, 4, DIFF_QK_DIM), 0.1),
        'diff_norm_g': gain(ks[12], (DEPTH, DIFF_V_DIM)),
        'nsa_cmp_pos': nrm(ks[13], (DEPTH, 2, CMP_BLOCK, NSA_DK), 0.02),
        'nsa_cmp_w1': nrm(ks[14], (DEPTH, 2, CMP_BLOCK * NSA_DK, CMP_HIDDEN), (CMP_BLOCK * NSA_DK) ** -0.5),
        'nsa_cmp_b1': nrm(ks[15], (DEPTH, 2, CMP_HIDDEN), 0.01),
        'nsa_cmp_w2': nrm(ks[16], (DEPTH, 2, CMP_HIDDEN, NSA_DK), CMP_HIDDEN ** -0.5),
        'nsa_gate_b': nrm(ks[17], (DEPTH, NSA_HEADS * 3), 0.01),
        'w_out': nrm(ks[18], (DEPTH, D_MIX, D_MODEL), D_MIX ** -0.5),
        'final_norm_g': gain(ks[19], (D_MODEL,)),
    }


def reference(x, ffn_norm_g, ffn_w_gate, ffn_w_up, ffn_w_down, mix_norm_g, w_in,
              mla_q_norm_g, mla_w_uq, mla_kv_norm_g, mla_w_ukv, diff_lambda, diff_norm_g,
              nsa_cmp_pos, nsa_cmp_w1, nsa_cmp_b1, nsa_cmp_w2, nsa_gate_b, w_out,
              final_norm_g):
    t = x.shape[1]
    cs_mla = rope_tables(t, MLA_ROPE_DIM)
    cs_diff = rope_tables(t, DIFF_QK_DIM)
    cs_nsa = rope_tables(t, NSA_DK)
    for l in range(DEPTH):
        lam_init = 0.8 - 0.6 * math.exp(-0.3 * l)
        x = x + 0.5 * swiglu(rms_norm(x, ffn_norm_g[l, 0]), ffn_w_gate[l, 0],
                             ffn_w_up[l, 0], ffn_w_down[l, 0])
        x = x + token_mixer(rms_norm(x, mix_norm_g[l]), w_in[l],
                            mla_q_norm_g[l], mla_w_uq[l], mla_kv_norm_g[l], mla_w_ukv[l],
                            diff_lambda[l], diff_norm_g[l], lam_init,
                            nsa_cmp_pos[l], nsa_cmp_w1[l], nsa_cmp_b1[l], nsa_cmp_w2[l],
                            nsa_gate_b[l], w_out[l], cs_mla, cs_diff, cs_nsa)
        x = x + 0.5 * swiglu(rms_norm(x, ffn_norm_g[l, 1]), ffn_w_gate[l, 1],
                             ffn_w_up[l, 1], ffn_w_down[l, 1])
    return rms_norm(x, final_norm_g)
```

```cpp
#include <hip/hip_runtime.h>
#include <hip/hip_cooperative_groups.h>
#include <cstdio>
#include <cstdint>
namespace cg = cooperative_groups;
__device__ __forceinline__ int make_tid(int wave0) { int t = wave0 * 64 + (int)__builtin_amdgcn_mbcnt_hi(~0u, __builtin_amdgcn_mbcnt_lo(~0u, 0u)); asm volatile("" : "+v"(t)); return t; }
__device__ __forceinline__ int opaque_bid() { int b = blockIdx.x; asm volatile("" : "+s"(b)); return b; }
namespace pg8 {
#define PG8_LAS __attribute__((address_space(3)))
typedef unsigned short bf16_t;
typedef short bf16x8 __attribute__((ext_vector_type(8)));
typedef float f32x4 __attribute__((ext_vector_type(4)));
typedef unsigned u32x4 __attribute__((ext_vector_type(4)));
constexpr int BM = 256, BK = 64, HALF = 128, HTB = HALF * BK * 2  , STAGE_BYTES = 8 * HTB, NXCD = 8, WGM = 8;

__host__ __device__ __forceinline__ int lds_byte(int r, int c) { const int st = (r >> 4) * 2 + (c >> 5), rr = r & 15, cc = c & 31, ob = rr * 64 + cc * 2; return st * 1024 + (ob ^ (((ob >> 9) & 1) << 5)); }
__host__ __device__ __forceinline__ void stage_rc(int b, int& R, int& C) { const int st = b / 1024, sb = b % 1024, swz = sb ^ (((sb >> 9) & 1) << 5); R = (st >> 1) * 16 + swz / 64; C = (st & 1) * 32 + (swz % 64) / 2; }
__host__ __device__ __forceinline__ int perm32(int rho) { const int n = rho >> 4, i = rho & 15; return 8 * (i >> 2) + 4 * n + (i & 3); }

struct Unit { int pm, pn; };
struct Gemm { const bf16_t* A; const bf16_t* Bt; int M, N, K; };

struct StaticOrder {
    int nM, nN, nwg, G, c;
    __host__ __device__ void init(int M, int N, int G_, int c_) { nM = M / BM; nN = N / BM; nwg = nM * nN; G = G_; c = c_; }
    __host__ __device__ bool next(int i, Unit& u) const {
        const long L = (long)i * G + c; if (L >= nwg) return false;
        int wgid = (int)L; { const int q = nwg / NXCD, r = nwg % NXCD, xcd = wgid % NXCD, off = wgid / NXCD; wgid = (xcd < r ? xcd * (q + 1) : r * (q + 1) + (xcd - r) * q) + off; }
        const int nig = WGM * nN, gid = wgid / nig, fm = gid * WGM, gsz = (nM - fm) < WGM ? (nM - fm) : WGM;
        u.pm = fm + ((wgid % nig) % gsz); u.pn = (wgid % nig) / gsz; return true;
    }
    __device__ __forceinline__ void a_ready(const Unit&) const {}
    __device__ __forceinline__ void done(const Unit&) const {}
};

__device__ __forceinline__ unsigned cvt_pk_bf16(float lo, float hi) { unsigned r; asm volatile("v_cvt_pk_bf16_f32 %0, %1, %2" : "=v"(r) : "v"(lo), "v"(hi)); return r; }
typedef float f32x2 __attribute__((ext_vector_type(2)));
template <class Epi, class Sched, bool ALIGN_EPI = false, bool SP2 = false>
__device__ __forceinline__ void gemm_phase(PG8_LAS unsigned char* lds, const Gemm g, const Sched& S, const Epi& E, const int wave0) {
    const int tid = make_tid(wave0), wid = wave0, lane = tid & 63, wr = wid >> 2, wc = wid & 3, fr = lane & 15, fq = lane >> 4;
    const int K = g.K, nt = K / BK;
    unsigned voffA[2], voffB[2];
#pragma unroll
    for (int i = 0; i < 2; ++i) { int R, C; stage_rc(tid * 16 + i * 8192, R, C); const int Rb = Epi::PERM ? ((R & ~31) + perm32(R & 31)) : R;
        voffA[i] = (unsigned)(R * K + C) * 2u; voffB[i] = (unsigned)(Rb * K + C) * 2u; }
    const size_t kstep = (size_t)(BK * 2);
    const size_t hstep = (size_t)HALF * K * 2;
    const size_t tstep = 2 * hstep;
    const unsigned ldsw = (unsigned)wid * 1024u;
    const int aoff = lds_byte(wr * 64 + fr, fq * 8), boff = lds_byte(wc * 32 + fr, fq * 8);
#define PG8_SA(b, h) (((b) * 2 + (h)) * HTB)
#define PG8_SB(b, h) ((4 + (b) * 2 + (h)) * HTB)
#define PG8_STAGE(bufoff, gbase, voff) do { _Pragma("unroll") for (int _i = 0; _i < 2; ++_i) \
        __builtin_amdgcn_global_load_lds((const unsigned*)((const char*)(gbase) + (voff)[_i]), (PG8_LAS unsigned*)(lds + (bufoff) + ldsw + _i * 8192), 16, 0, 0); } while (0)
#define PG8_LDA(dst, b, h) do { _Pragma("unroll") for (int m = 0; m < 4; ++m) _Pragma("unroll") for (int k = 0; k < 2; ++k) dst[m][k] = *(const PG8_LAS bf16x8*)(lds + PG8_SA(b, h) + aoff + m * 2048 + k * 1024); } while (0)
#define PG8_LDB(dst, b, h) do { _Pragma("unroll") for (int n = 0; n < 2; ++n) _Pragma("unroll") for (int k = 0; k < 2; ++k) dst[n][k] = *(const PG8_LAS bf16x8*)(lds + PG8_SB(b, h) + boff + n * 2048 + k * 1024); } while (0)
#define PG8_MMA(ai, bj, At, Bt) do { __builtin_amdgcn_s_setprio(1); _Pragma("unroll") for (int m = 0; m < 4; ++m) _Pragma("unroll") for (int n = 0; n < 2; ++n) _Pragma("unroll") for (int k = 0; k < 2; ++k) \
        acc[ai][bj][m][n] = __builtin_amdgcn_mfma_f32_16x16x32_bf16(Bt[n][k], At[m][k], acc[ai][bj][m][n], 0, 0, 0); __builtin_amdgcn_s_setprio(0); } while (0)
#define PG8_WAIT_V(n) asm volatile("s_waitcnt vmcnt(" #n ")" ::: "memory")
#define PG8_WAIT_L(n) asm volatile("s_waitcnt lgkmcnt(" #n ")" ::: "memory")
#define PG8_BAR __builtin_amdgcn_s_barrier()
#define PG8_SCHED __builtin_amdgcn_sched_barrier(0)
    Unit cur, nxt; int ui = 0;
    if (!S.next(0, cur)) return;
    f32x4 acc[2][2][4][2];
#pragma unroll
    for (int a = 0; a < 2; ++a)
#pragma unroll
        for (int b = 0; b < 2; ++b)
#pragma unroll
            for (int m = 0; m < 4; ++m)
#pragma unroll
                for (int n = 0; n < 2; ++n) acc[a][b][m][n] = (f32x4){0.f, 0.f, 0.f, 0.f};
    bf16x8 At[4][2], B0[2][2], B1[2][2];
    const char* cA = (const char*)g.A + (size_t)cur.pm * tstep; const char* cB = (const char*)g.Bt + (size_t)cur.pn * tstep;
    S.a_ready(cur);
    if constexpr (SP2) {
        PG8_STAGE(PG8_SB(0, 0), cB, voffB); PG8_STAGE(PG8_SB(0, 1), cB + hstep, voffB); PG8_STAGE(PG8_SA(0, 0), cA, voffA); PG8_STAGE(PG8_SA(0, 1), cA + hstep, voffA);
        if (wr == 1) PG8_BAR;
        PG8_WAIT_V(2); PG8_BAR;
        PG8_STAGE(PG8_SB(1, 0), cB + kstep, voffB); PG8_STAGE(PG8_SA(1, 0), cA + kstep, voffA); PG8_STAGE(PG8_SB(1, 1), cB + hstep + kstep, voffB);
        PG8_WAIT_V(6); PG8_BAR;
    } else {
        PG8_STAGE(PG8_SB(0, 0), cB, voffB); PG8_STAGE(PG8_SA(0, 0), cA, voffA); PG8_STAGE(PG8_SB(0, 1), cB + hstep, voffB); PG8_STAGE(PG8_SA(0, 1), cA + hstep, voffA);
        if (wr == 1) PG8_BAR;
        PG8_WAIT_V(4); PG8_BAR;
        PG8_STAGE(PG8_SB(1, 0), cB + kstep, voffB); PG8_STAGE(PG8_SA(1, 0), cA + kstep, voffA); PG8_STAGE(PG8_SB(1, 1), cB + hstep + kstep, voffB);
        PG8_WAIT_V(6); PG8_BAR;
    }
    for (;;) {
        const bool has_next = S.next(ui + 1, nxt);
        const char* nA = has_next ? (const char*)g.A + (size_t)nxt.pm * tstep : cA; const char* nB = has_next ? (const char*)g.Bt + (size_t)nxt.pn * tstep : cB;
        for (int t = 0; t < nt; t += 2) {
            const bool last = (t == nt - 2);
            const char* a1 = cA + (size_t)(t + 1) * kstep;
            const char* a2 = last ? nA : cA + (size_t)(t + 2) * kstep; const char* b2 = last ? nB : cB + (size_t)(t + 2) * kstep;
            const char* a3 = a2 + kstep; const char* b3 = b2 + kstep;
            if (last && has_next) S.a_ready(nxt);
            if constexpr (SP2) {
            PG8_LDB(B0, 0, 0); PG8_LDB(B1, 0, 1); PG8_SCHED; PG8_LDA(At, 0, 0); PG8_STAGE(PG8_SA(1, 1), a1 + hstep, voffA);
            PG8_WAIT_V(8); PG8_WAIT_L(0); PG8_BAR; PG8_MMA(0, 0, At, B0); PG8_MMA(0, 1, At, B1); PG8_BAR; PG8_SCHED;
            PG8_LDA(At, 0, 1); PG8_STAGE(PG8_SB(0, 0), b2, voffB); PG8_STAGE(PG8_SB(0, 1), b2 + hstep, voffB); PG8_STAGE(PG8_SA(0, 0), a2, voffA);
            PG8_WAIT_V(8); PG8_WAIT_L(0); PG8_BAR; PG8_MMA(1, 0, At, B0); PG8_MMA(1, 1, At, B1); PG8_BAR; PG8_SCHED;
            PG8_LDB(B0, 1, 0); PG8_LDB(B1, 1, 1); PG8_SCHED; PG8_LDA(At, 1, 0); PG8_STAGE(PG8_SA(0, 1), a2 + hstep, voffA);
            PG8_WAIT_V(8); PG8_WAIT_L(0); PG8_BAR; PG8_MMA(0, 0, At, B0); PG8_MMA(0, 1, At, B1); PG8_BAR; PG8_SCHED;
            PG8_LDA(At, 1, 1); PG8_STAGE(PG8_SB(1, 0), b3, voffB); PG8_STAGE(PG8_SB(1, 1), b3 + hstep, voffB); PG8_STAGE(PG8_SA(1, 0), a3, voffA);
            PG8_WAIT_V(8); PG8_WAIT_L(0); PG8_BAR; PG8_MMA(1, 0, At, B0); PG8_MMA(1, 1, At, B1); PG8_BAR; PG8_SCHED;
            } else {
            PG8_LDB(B0, 0, 0); PG8_SCHED; PG8_LDA(At, 0, 0); PG8_STAGE(PG8_SA(1, 1), a1 + hstep, voffA);
            PG8_WAIT_L(8); PG8_BAR; PG8_WAIT_L(0); PG8_MMA(0, 0, At, B0); PG8_BAR; PG8_SCHED;
            PG8_LDB(B1, 0, 1); PG8_STAGE(PG8_SB(0, 0), b2, voffB);
            PG8_BAR; PG8_WAIT_L(0); PG8_MMA(0, 1, At, B1); PG8_BAR;
            PG8_LDA(At, 0, 1); PG8_STAGE(PG8_SA(0, 0), a2, voffA);
            PG8_BAR; PG8_WAIT_L(0); PG8_MMA(1, 0, At, B0); PG8_BAR; PG8_SCHED;
            PG8_STAGE(PG8_SB(0, 1), b2 + hstep, voffB);
            PG8_WAIT_V(6); PG8_BAR; PG8_MMA(1, 1, At, B1); PG8_BAR;
            PG8_LDB(B0, 1, 0); PG8_SCHED; PG8_LDA(At, 1, 0); PG8_STAGE(PG8_SA(0, 1), a2 + hstep, voffA);
            PG8_WAIT_L(8); PG8_BAR; PG8_WAIT_L(0); PG8_MMA(0, 0, At, B0); PG8_BAR; PG8_SCHED;
            PG8_LDB(B1, 1, 1); PG8_STAGE(PG8_SB(1, 0), b3, voffB);
            PG8_BAR; PG8_WAIT_L(0); PG8_MMA(0, 1, At, B1); PG8_BAR;
            PG8_LDA(At, 1, 1); PG8_STAGE(PG8_SA(1, 0), a3, voffA);
            PG8_BAR; PG8_WAIT_L(0); PG8_MMA(1, 0, At, B0); PG8_BAR; PG8_SCHED;
            PG8_STAGE(PG8_SB(1, 1), b3 + hstep, voffB);
            PG8_WAIT_V(6); PG8_BAR; PG8_MMA(1, 1, At, B1); PG8_BAR;
            }
        }
        if constexpr (ALIGN_EPI) { if (wr == 0) PG8_BAR; }
        if constexpr (!Epi::AFTER_DRAIN) { E(acc, cur, wr, wc, fr, fq); S.done(cur); }
        if (!has_next) break;
#pragma unroll
        for (int a = 0; a < 2; ++a)
#pragma unroll
            for (int b = 0; b < 2; ++b)
#pragma unroll
                for (int m = 0; m < 4; ++m)
#pragma unroll
                    for (int n = 0; n < 2; ++n) acc[a][b][m][n] = (f32x4){0.f, 0.f, 0.f, 0.f};
        cur = nxt; cA = nA; cB = nB; ++ui;
        if constexpr (ALIGN_EPI) { if (wr == 1) PG8_BAR; }
    }
    PG8_WAIT_V(0);
    if constexpr (!ALIGN_EPI) { if (wr == 0) PG8_BAR; }
    PG8_BAR;
    if constexpr (Epi::AFTER_DRAIN) { E.fused(acc, cur, wr, wc, fr, fq, lds, wid, lane); S.done(cur); }
#undef PG8_SA
#undef PG8_SB
#undef PG8_STAGE
#undef PG8_LDA
#undef PG8_LDB
#undef PG8_MMA
#undef PG8_WAIT_V
#undef PG8_WAIT_L
#undef PG8_BAR
#undef PG8_SCHED
}
}

#define LAS __attribute__((address_space(3)))
#define GAS __attribute__((address_space(1)))
typedef unsigned short bf16_t;
typedef short bf16x8 __attribute__((ext_vector_type(8)));
typedef float f32x4 __attribute__((ext_vector_type(4)));
typedef float f32x2 __attribute__((ext_vector_type(2)));
typedef float f32x16 __attribute__((ext_vector_type(16)));
typedef unsigned u32x4 __attribute__((ext_vector_type(4)));
typedef unsigned u32x2 __attribute__((ext_vector_type(2)));
typedef short v4i16_t __attribute__((ext_vector_type(4)));
typedef __bf16 bf16x2_t __attribute__((ext_vector_type(2)));

constexpr int BATCH = 8, SEQ = 4096, DM = 1024, FF = 2816, NPJ = 2560, NIN = 2488;
constexpr int MROWS = BATCH * SEQ;
constexpr float EPS = 1e-6f;
constexpr float LOG2E = 1.4426950408889634f;
constexpr int C_CQ = 0, C_CKV = 256, C_KR = 384, C_DQ = 416, C_DK = 672, C_DV = 928, C_NQ = 1184, C_NKV = 1696, C_NG = 2464;
constexpr float QS_MLA = 0.14724444602590306f;
constexpr float QS_DIFF = 0.25503486164919736f;
constexpr float QS_NSA = 0.18033688011112042f;

constexpr size_t al256(size_t x) { return (x + 255) & ~(size_t)255; }
constexpr size_t WS_CTL = 0;
constexpr size_t WS_PTAB = 3072;
constexpr size_t WS_TAB32 = 4096;
constexpr size_t WS_TAB64 = WS_TAB32 + (size_t)SEQ * 16 * 8;
constexpr size_t WS_WGU = WS_TAB64 + (size_t)SEQ * 32 * 8;
constexpr size_t SZ_WGU = (size_t)2 * FF * DM * 2;
constexpr size_t WS_WD = WS_WGU + 4 * SZ_WGU;
constexpr size_t SZ_WD = (size_t)DM * FF * 2;
constexpr size_t WS_WIN = WS_WD + 4 * SZ_WD;
constexpr size_t SZ_WIN = (size_t)NPJ * DM * 2;
constexpr size_t WS_WOUT = WS_WIN + 2 * SZ_WIN;
constexpr size_t SZ_WOUT = (size_t)DM * DM * 2;
constexpr size_t WS_WUQ = WS_WOUT + 2 * SZ_WOUT;
constexpr size_t SZ_WUQ = (size_t)512 * 256 * 2;
constexpr size_t WS_WUKV = WS_WUQ + 2 * SZ_WUQ;
constexpr size_t SZ_WUKV = (size_t)512 * 128 * 2;
constexpr size_t WS_W1 = WS_WUKV + 2 * SZ_WUKV;
constexpr size_t SZ_W1 = (size_t)256 * 2048 * 2;
constexpr size_t WS_W2 = WS_W1 + 4 * SZ_W1;
constexpr size_t SZ_W2 = (size_t)256 * 256 * 2;
constexpr size_t WS_HN = WS_W2 + 4 * SZ_W2;
constexpr size_t WS_ACT = WS_HN + (size_t)MROWS * DM * 2;
constexpr size_t WS_QM = WS_ACT + (size_t)MROWS * FF * 2;
constexpr size_t WS_KMLA = WS_QM + (size_t)MROWS * 384 * 2;
constexpr size_t WS_HN2 = WS_QM;
constexpr size_t WS_VMLA = WS_KMLA + (size_t)MROWS * 384 * 2;
constexpr size_t WS_CQN = WS_VMLA + (size_t)MROWS * 256 * 2;
constexpr size_t WS_CKVN = WS_CQN + (size_t)MROWS * 256 * 2;
constexpr size_t WS_FLATK = WS_CKVN + (size_t)MROWS * 128 * 2;
constexpr size_t WS_FLATV = WS_FLATK + (size_t)4096 * 2048 * 2;
constexpr size_t WS_HIDK = WS_FLATV + (size_t)4096 * 2048 * 2;
constexpr size_t WS_HIDV = WS_HIDK + (size_t)4096 * 256 * 2;
constexpr size_t WS_KC = WS_HIDV + (size_t)4096 * 256 * 2;
constexpr size_t WS_VC = WS_KC + (size_t)4096 * 64 * 2;
constexpr size_t WS_GATES = WS_VC + (size_t)4096 * 64 * 2;
constexpr size_t WS_MASK = WS_GATES + (size_t)MROWS * 24 * 4;
constexpr size_t WS_OCMP = WS_MASK + (size_t)16 * SEQ * 8;
constexpr size_t WS_BAR = WS_OCMP + (size_t)MROWS * 512 * 2;
constexpr size_t WS_SS = WS_BAR + 16384;
constexpr size_t WS_END = WS_SS + (size_t)6 * MROWS * 4;

constexpr int LDS_BYTES = 147456;
constexpr int MISC_OFF = 147456 - 512;
constexpr int SC_OFF = 69632;
constexpr int MI_OFF = SC_OFF + 8 * 32 * 65 * 4;
static_assert(MI_OFF + 8 * 1024 <= MISC_OFF, "cmp LDS map");
static_assert(WS_CQN - WS_QM == (size_t)MROWS * DM * 2, "HN2 overlay");
constexpr int NTHR = 512;

__device__ __forceinline__ float bf2f(bf16_t h) { return __uint_as_float((unsigned)h << 16); }
__device__ __forceinline__ unsigned cvtpk(float lo, float hi) { f32x2 v = {lo, hi}; bf16x2_t b = __builtin_convertvector(v, bf16x2_t); return __builtin_bit_cast(unsigned, b); }
__device__ __forceinline__ bf16_t f2bf(float f) { return (bf16_t)(cvtpk(f, 0.f) & 0xffffu); }
#define SWZ_XOR(v, m) __uint_as_float((unsigned)__builtin_amdgcn_ds_swizzle((int)__float_as_uint(v), ((m) << 10) | 0x1f))
__device__ __forceinline__ float sum32x(float v) { auto rr = __builtin_amdgcn_permlane32_swap(__float_as_uint(v), __float_as_uint(v), false, false); return __uint_as_float(rr[0]) + __uint_as_float(rr[1]); }
__device__ __forceinline__ float max32x(float v) { auto rr = __builtin_amdgcn_permlane32_swap(__float_as_uint(v), __float_as_uint(v), false, false); return fmaxf(__uint_as_float(rr[0]), __uint_as_float(rr[1])); }
__device__ __forceinline__ unsigned or32x(unsigned v) { auto rr = __builtin_amdgcn_permlane32_swap(v, v, false, false); return rr[0] | rr[1]; }
__device__ __forceinline__ float partner32(float v, int hi) { auto rr = __builtin_amdgcn_permlane32_swap(__float_as_uint(v), __float_as_uint(v), false, false); return __uint_as_float(hi ? rr[0] : rr[1]); }
__device__ __forceinline__ float wave_sum(float v) {
    v += SWZ_XOR(v, 1); v += SWZ_XOR(v, 2); v += SWZ_XOR(v, 4); v += SWZ_XOR(v, 8); v += SWZ_XOR(v, 16);
    return sum32x(v);
}
__device__ __forceinline__ float silu_f(float x) { return x * __builtin_amdgcn_rcpf(1.0f + __builtin_amdgcn_exp2f(-LOG2E * x)); }
__device__ __forceinline__ int crow(int r, int hi) { return (r & 3) + 8 * (r >> 2) + 4 * hi; }
#define LDS_WAIT() asm volatile("s_waitcnt lgkmcnt(0)" ::: "memory")
__device__ __forceinline__ float max3f(float a, float b, float c) { float r; asm("v_max3_f32 %0, %1, %2, %3" : "=v"(r) : "v"(a), "v"(b), "v"(c)); return r; }
__device__ __forceinline__ float fadd_s(float a, float b) { float r; asm("v_add_f32_e32 %0, %1, %2" : "=v"(r) : "v"(a), "v"(b)); return r; }

enum { EK_ACT = 0, EK_RES = 1, EK_BF16 = 2, EK_QUP = 3, EK_KVUP = 4 };
struct EpiP { int kind, ldc, ncols, flags; float coef; int pad; const GAS float* fin; GAS float* fout; GAS bf16_t* o0; GAS bf16_t* o1; const GAS float* aux; };
template <bool PERM_> struct EpiGenT {
    static constexpr bool PERM = PERM_, AFTER_DRAIN = false;
    const EpiP* p;
    __device__ __forceinline__ void operator()(const pg8::f32x4 (&acc)[2][2][4][2], const pg8::Unit& u, int wr, int wc, int fr, int fq) const {
        const int kind = p->kind, ldc = p->ldc, ncols = p->ncols, flags = p->flags; const float coef = p->coef;
        const float* fin = (const float*)p->fin; float* fout = (float*)p->fout; bf16_t* o0 = (bf16_t*)p->o0; bf16_t* o1 = (bf16_t*)p->o1; const float* aux = (const float*)p->aux;
        const int rowb = u.pm * 256 + wr * 64 + fr;
        const int colb = u.pn * 256 + wc * 32 + (PERM ? 8 : 4) * fq;
        constexpr int NS = PERM ? 4 : 16;
        if (kind == EK_ACT) {
            float rsv[2][4];
#pragma unroll
            for (int ai = 0; ai < 2; ++ai)
#pragma unroll
                for (int m = 0; m < 4; ++m) rsv[ai][m] = fin[rowb + 128 * ai + 16 * m];
#pragma unroll
            for (int ai = 0; ai < 2; ++ai)
#pragma unroll
                for (int m = 0; m < 4; ++m) {
                    bf16_t* rp = o0 + (size_t)(rowb + 128 * ai + 16 * m) * ldc + u.pn * 128 + wc * 32 + (PERM ? 8 : 4) * fq;
                    const float rs = __builtin_amdgcn_rsqf(rsv[ai][m] * (1.0f / DM) + EPS);
                    u32x2 wn[2];
#pragma unroll
                    for (int n = 0; n < 2; ++n) {
                        const pg8::f32x4 g = acc[ai][0][m][n] * rs, up = acc[ai][1][m][n] * rs;
                        wn[n].x = cvtpk(silu_f(g[0]) * up[0], silu_f(g[1]) * up[1]); wn[n].y = cvtpk(silu_f(g[2]) * up[2], silu_f(g[3]) * up[3]);
                    }
                    if (PERM) { *(u32x4*)rp = (u32x4){wn[0].x, wn[0].y, wn[1].x, wn[1].y}; }
                    else { *(u32x2*)rp = wn[0]; *(u32x2*)(rp + 16) = wn[1]; }
                }
        } else if (kind == EK_RES) {
#pragma unroll
            for (int ai = 0; ai < 2; ++ai) {
                pg8::f32x4 pre[4][2][2];
#pragma unroll
                for (int m = 0; m < 4; ++m) {
                    const size_t ro = (size_t)(rowb + 128 * ai + 16 * m) * ldc + colb;
#pragma unroll
                    for (int bj = 0; bj < 2; ++bj)
#pragma unroll
                        for (int n = 0; n < 2; ++n) pre[m][bj][n] = *(const pg8::f32x4*)(fin + ro + 128 * bj + NS * n);
                }
#pragma unroll
                for (int m = 0; m < 4; ++m) {
                    const size_t ro = (size_t)(rowb + 128 * ai + 16 * m) * ldc + colb;
                    float ssr = 0.f;
#pragma unroll
                    for (int bj = 0; bj < 2; ++bj)
#pragma unroll
                        for (int n = 0; n < 2; ++n) {
                            const size_t off = ro + 128 * bj + NS * n;
                            const pg8::f32x4 v = pre[m][bj][n] + acc[ai][bj][m][n] * coef;
                            *(pg8::f32x4*)(fout + off) = v;
                            if (flags & 2) { u32x2 w; w.x = cvtpk(v[0], v[1]); w.y = cvtpk(v[2], v[3]); *(u32x2*)(o0 + off) = w; ssr += (v[0] * v[0] + v[1] * v[1]) + (v[2] * v[2] + v[3] * v[3]); }
                        }
                    if (flags & 2) { ssr += SWZ_XOR(ssr, 16); ssr = sum32x(ssr); if (fq == 0) atomicAdd((float*)o1 + (rowb + 128 * ai + 16 * m), ssr); }
                }
                asm volatile("" ::: "memory");
            }
        } else if (kind == EK_BF16 && PERM) {
#pragma unroll
            for (int bj = 0; bj < 2; ++bj) {
                const int c = colb + 128 * bj;
                if (c < ncols) {
#pragma unroll
                    for (int ai = 0; ai < 2; ++ai)
#pragma unroll
                        for (int m = 0; m < 4; ++m) {
                            pg8::f32x4 v0 = acc[ai][bj][m][0], v1 = acc[ai][bj][m][1];
                            if (flags & 4) { const float rs = __builtin_amdgcn_rsqf(fin[rowb + 128 * ai + 16 * m] * (1.0f / DM) + EPS); v0 = v0 * rs; v1 = v1 * rs; }
                            *(u32x4*)(o0 + (size_t)(rowb + 128 * ai + 16 * m) * ldc + c) = (u32x4){cvtpk(v0[0], v0[1]), cvtpk(v0[2], v0[3]), cvtpk(v1[0], v1[1]), cvtpk(v1[2], v1[3])};
                        }
                }
            }
        } else if (kind == EK_BF16) {
#pragma unroll
            for (int bj = 0; bj < 2; ++bj)
#pragma unroll
                for (int n = 0; n < 2; ++n) {
                    const int c = colb + 128 * bj + NS * n;
                    if (c < ncols) {
                        pg8::f32x4 bv = (pg8::f32x4){0.f, 0.f, 0.f, 0.f};
                        if (aux) bv = *(const pg8::f32x4*)(aux + c);
#pragma unroll
                        for (int ai = 0; ai < 2; ++ai)
#pragma unroll
                            for (int m = 0; m < 4; ++m) {
                                pg8::f32x4 v = acc[ai][bj][m][n] + bv;
                                if (flags & 4) v = v * __builtin_amdgcn_rsqf(fin[rowb + 128 * ai + 16 * m] * (1.0f / DM) + EPS);
                                if (flags & 1) { v[0] = silu_f(v[0]); v[1] = silu_f(v[1]); v[2] = silu_f(v[2]); v[3] = silu_f(v[3]); }
                                u32x2 w; w.x = cvtpk(v[0], v[1]); w.y = cvtpk(v[2], v[3]);
                                *(u32x2*)(o0 + (size_t)(rowb + 128 * ai + 16 * m) * ldc + c) = w;
                            }
                    }
                }
        } else if (PERM) {
        } else if (kind == EK_QUP) {
#pragma unroll
            for (int bj = 0; bj < 2; ++bj) {
                const int cg32 = u.pn * 256 + 128 * bj + wc * 32;
                if (cg32 < 384) {
                    const bool rope = ((cg32 >> 5) % 3) == 2;
#pragma unroll
                    for (int ai = 0; ai < 2; ++ai)
#pragma unroll
                        for (int m = 0; m < 4; ++m) {
                            const int row = rowb + 128 * ai + 16 * m;
                            pg8::f32x4 x1 = acc[ai][bj][m][0], x2 = acc[ai][bj][m][1];
                            if (rope) {
                                const float* tp = aux + ((size_t)(row & (SEQ - 1)) * 16 + 4 * fq) * 2;
                                const pg8::f32x4 cs0 = *(const pg8::f32x4*)tp, cs1 = *(const pg8::f32x4*)(tp + 4);
                                const pg8::f32x4 cc = {cs0[0], cs0[2], cs1[0], cs1[2]}, ss = {cs0[1], cs0[3], cs1[1], cs1[3]};
                                const pg8::f32x4 y1 = x1 * cc - x2 * ss, y2 = x2 * cc + x1 * ss;
                                x1 = y1; x2 = y2;
                            }
                            x1 = x1 * QS_MLA; x2 = x2 * QS_MLA;
                            bf16_t* rp = o0 + (size_t)row * 384 + cg32 + 4 * fq;
                            u32x2 w; w.x = cvtpk(x1[0], x1[1]); w.y = cvtpk(x1[2], x1[3]); *(u32x2*)rp = w;
                            w.x = cvtpk(x2[0], x2[1]); w.y = cvtpk(x2[2], x2[3]); *(u32x2*)(rp + 16) = w;
                        }
                }
            }
        } else {
#pragma unroll
            for (int bj = 0; bj < 2; ++bj)
#pragma unroll
                for (int n = 0; n < 2; ++n) {
                    const int c = colb + 128 * bj + NS * n;
                    const int head = c >> 7, isv = (c >> 6) & 1, d = c & 63;
#pragma unroll
                    for (int ai = 0; ai < 2; ++ai)
#pragma unroll
                        for (int m = 0; m < 4; ++m) {
                            const int row = rowb + 128 * ai + 16 * m;
                            const pg8::f32x4 v = acc[ai][bj][m][n];
                            u32x2 w; w.x = cvtpk(v[0], v[1]); w.y = cvtpk(v[2], v[3]);
                            bf16_t* p = isv ? (o1 + (size_t)row * 256 + head * 64 + d) : (o0 + (size_t)row * 384 + head * 96 + d);
                            *(u32x2*)p = w;
                        }
                }
        }
    }
};

struct GemmDesc { const bf16_t* A; const bf16_t* Bt; int M, N, K, rot; EpiP e; };

__device__ __forceinline__ void transpose_mat(const float* __restrict__ W, int K, int N, int Npad, bf16_t* __restrict__ WT, int blk_mul, int blk_off,
                                              LAS float* scr, int gw, int NGW, int lane, const float* __restrict__ gk = nullptr) {
    const int nblk = Npad / 32, nitems = (K / 64) * nblk;
    for (int it = gw; it < nitems; it += NGW) {
        const int kb = it / nblk, nb = it % nblk, k0 = 64 * kb, n0 = 32 * nb;
        const int ncol = n0 + (lane & 31);
#pragma unroll
        for (int i = 0; i < 32; ++i) { const int kk = 2 * i + (lane >> 5); float w = (ncol < N) ? W[(size_t)(k0 + kk) * N + ncol] : 0.f; if (gk) w *= gk[k0 + kk]; scr[kk * 33 + (lane & 31)] = w; }
        LDS_WAIT();
        const int c = lane & 7;
#pragma unroll
        for (int j = 0; j < 4; ++j) {
            const int n = (lane >> 3) + 8 * j; const LAS float* s = scr + (8 * c) * 33 + n;
            u32x4 o; o.x = cvtpk(s[0 * 33], s[1 * 33]); o.y = cvtpk(s[2 * 33], s[3 * 33]); o.z = cvtpk(s[4 * 33], s[5 * 33]); o.w = cvtpk(s[6 * 33], s[7 * 33]);
            const int nn = n0 + n, orow = (nn / 128) * blk_mul + blk_off + (nn % 128);
            *(u32x4*)(WT + (size_t)orow * K + k0 + 8 * c) = o;
        }
        LDS_WAIT();
    }
}

__device__ __forceinline__ void sincos_acc(float ang, float& c, float& s) {
    const double a = (double)ang;
    const double kq = __builtin_rint(a * 0.6366197723675814);
    double r = __builtin_fma(-kq, 1.5707963267948966, a);
    r = __builtin_fma(-kq, 6.123233995736766e-17, r);
    const double r2 = r * r;
    const double sp = r * (1.0 + r2 * (-1.0 / 6 + r2 * (1.0 / 120 + r2 * (-1.0 / 5040 + r2 * (1.0 / 362880 + r2 * (-1.0 / 39916800))))));
    const double cp = 1.0 + r2 * (-0.5 + r2 * (1.0 / 24 + r2 * (-1.0 / 720 + r2 * (1.0 / 40320 + r2 * (-1.0 / 3628800 + r2 * (1.0 / 479001600))))));
    const int q = ((int)kq) & 3;
    const double sv = (q == 0) ? sp : (q == 1) ? cp : (q == 2) ? -sp : -cp;
    const double cv = (q == 0) ? cp : (q == 1) ? -sp : (q == 2) ? -cp : sp;
    c = (float)cv; s = (float)sv;
}

__device__ __forceinline__ void norm_rows_bf16(const float* __restrict__ x, const float* __restrict__ g, bf16_t* __restrict__ out, int gw, int NGW, int lane) {
    for (int m = gw; m < MROWS; m += NGW) {
        const f32x4* xr = (const f32x4*)(x + (size_t)m * DM) + lane;
        f32x4 v[4]; float ss = 0.f;
#pragma unroll
        for (int j = 0; j < 4; ++j) { v[j] = xr[64 * j]; ss += (v[j][0] * v[j][0] + v[j][1] * v[j][1]) + (v[j][2] * v[j][2] + v[j][3] * v[j][3]); }
        const float rstd = 1.0f / sqrtf(wave_sum(ss) * (1.0f / DM) + EPS);
        u32x2* o8 = (u32x2*)(out + (size_t)m * DM) + lane;
#pragma unroll
        for (int j = 0; j < 4; ++j) { const f32x4 gv = ((const f32x4*)g)[lane + 64 * j];
            u32x2 w; w.x = cvtpk(v[j][0] * rstd * gv[0], v[j][1] * rstd * gv[1]); w.y = cvtpk(v[j][2] * rstd * gv[2], v[j][3] * rstd * gv[3]); o8[64 * j] = w; }
    }
}
__device__ __forceinline__ void norm_rows_f32_inplace(float* __restrict__ x, const float* __restrict__ g, int gw, int NGW, int lane) {
    for (int m = gw; m < MROWS; m += 2 * NGW) {
        const int m2 = m + NGW;
        f32x4* xa = (f32x4*)(x + (size_t)m * DM) + lane;
        f32x4* xb = (f32x4*)(x + (size_t)(m2 < MROWS ? m2 : m) * DM) + lane;
        f32x4 va[4], vb[4]; float sa = 0.f, sb = 0.f;
#pragma unroll
        for (int j = 0; j < 4; ++j) { va[j] = xa[64 * j]; vb[j] = xb[64 * j]; }
#pragma unroll
        for (int j = 0; j < 4; ++j) { sa += (va[j][0] * va[j][0] + va[j][1] * va[j][1]) + (va[j][2] * va[j][2] + va[j][3] * va[j][3]);
                                      sb += (vb[j][0] * vb[j][0] + vb[j][1] * vb[j][1]) + (vb[j][2] * vb[j][2] + vb[j][3] * vb[j][3]); }
        const float ra = 1.0f / sqrtf(wave_sum(sa) * (1.0f / DM) + EPS), rb = 1.0f / sqrtf(wave_sum(sb) * (1.0f / DM) + EPS);
#pragma unroll
        for (int j = 0; j < 4; ++j) { const f32x4 gv = ((const f32x4*)g)[lane + 64 * j]; __builtin_nontemporal_store(va[j] * ra * gv, xa + 64 * j); if (m2 < MROWS) __builtin_nontemporal_store(vb[j] * rb * gv, xb + 64 * j); }
    }
}

struct PostRegs {
    u32x2 r_cq; unsigned r_ckv; unsigned r_kr1, r_kr2; unsigned dq1, dq2, dk1, dk2, nq1[2], nq2[2], nk1[2], nk2[2];
    unsigned r_v; bf16_t r_gate; f32x4 cs32, cs64; f32x2 pk0a, pk0b, pk1a, pk1b, pv0, pv1;
};
__device__ __forceinline__ float bflo(unsigned u) { return __uint_as_float(u << 16); }
__device__ __forceinline__ float bfhi(unsigned u) { return __uint_as_float(u & 0xffff0000u); }
__device__ __forceinline__ void post_load(PostRegs& R, int m, int lane, const bf16_t* __restrict__ P, const float* __restrict__ tab32, const float* __restrict__ tab64,
                                          const float* __restrict__ posK, const float* __restrict__ posV) {
    const bf16_t* pr = P + (size_t)m * NPJ;
    const int t = m & (SEQ - 1);
    const int i16 = 2 * (lane & 7), i32 = 2 * (lane & 15);
    R.r_cq = *(const u32x2*)(pr + C_CQ + 4 * lane);
    R.r_ckv = *(const unsigned*)(pr + C_CKV + 2 * lane);
    R.r_kr1 = *(const unsigned*)(pr + C_KR + i16); R.r_kr2 = *(const unsigned*)(pr + C_KR + 16 + i16);
    { const int ch = lane >> 3;
      R.dq1 = *(const unsigned*)(pr + C_DQ + ch * 32 + i16); R.dq2 = *(const unsigned*)(pr + C_DQ + ch * 32 + 16 + i16);
      R.dk1 = *(const unsigned*)(pr + C_DK + ch * 32 + i16); R.dk2 = *(const unsigned*)(pr + C_DK + ch * 32 + 16 + i16); }
#pragma unroll
    for (int rep = 0; rep < 2; ++rep) { const int ch = (lane + 64 * rep) >> 4; R.nq1[rep] = *(const unsigned*)(pr + C_NQ + ch * 64 + i32); R.nq2[rep] = *(const unsigned*)(pr + C_NQ + ch * 64 + 32 + i32); }
#pragma unroll
    for (int rep = 0; rep < 2; ++rep) { int ch = (lane + 64 * rep) >> 4; ch = ch < 6 ? ch : 5; const int br = ch >> 1, g = ch & 1;
        R.nk1[rep] = *(const unsigned*)(pr + C_NKV + br * 256 + g * 64 + i32); R.nk2[rep] = *(const unsigned*)(pr + C_NKV + br * 256 + g * 64 + 32 + i32); }
    const int vg = (2 * lane) >> 6, vd = (2 * lane) & 63;
    R.r_v = *(const unsigned*)(pr + C_NKV + 128 + vg * 64 + vd);
    R.r_gate = pr[C_NG + (lane < 24 ? lane : 23)];
    R.cs32 = *(const f32x4*)(tab32 + (size_t)t * 32 + 2 * i16);
    R.cs64 = *(const f32x4*)(tab64 + (size_t)t * 64 + 2 * i32);
    const int l0 = t & 15, l1 = l0 + 16;
    R.pk0a = *(const f32x2*)(posK + l0 * 64 + i32); R.pk0b = *(const f32x2*)(posK + l0 * 64 + 32 + i32);
    R.pk1a = *(const f32x2*)(posK + l1 * 64 + i32); R.pk1b = *(const f32x2*)(posK + l1 * 64 + 32 + i32);
    R.pv0 = *(const f32x2*)(posV + l0 * 64 + vd); R.pv1 = *(const f32x2*)(posV + l1 * 64 + vd);
}
#define ROPE2(a, b2, cs, y1a, y1b, y2a, y2b) \
    const float y1a = bflo(a) * cs[0] - bflo(b2) * cs[1], y2a = bflo(b2) * cs[0] + bflo(a) * cs[1]; \
    const float y1b = bfhi(a) * cs[2] - bfhi(b2) * cs[3], y2b = bfhi(b2) * cs[2] + bfhi(a) * cs[3];
__device__ __forceinline__ void post_store(const PostRegs& R, int m, int lane, bf16_t* __restrict__ P, const f32x4 g4, const f32x2 g2, const float gb,
        bf16_t* __restrict__ cqn, bf16_t* __restrict__ ckvn, bf16_t* __restrict__ Kmla, bf16_t* __restrict__ flatK, bf16_t* __restrict__ flatV, float* __restrict__ gates) {
    bf16_t* pr = P + (size_t)m * NPJ;
    const int t = m & (SEQ - 1), b = m >> 12;
    const int i16 = 2 * (lane & 7), i32 = 2 * (lane & 15);
    const int l0 = t & 15, nc0 = t >> 4, l1 = l0 + 16;
    const int vg = (2 * lane) >> 6, vd = (2 * lane) & 63;
    {
        const float v0 = bflo(R.r_cq.x), v1 = bfhi(R.r_cq.x), v2 = bflo(R.r_cq.y), v3 = bfhi(R.r_cq.y);
        const float ss = wave_sum((v0 * v0 + v1 * v1) + (v2 * v2 + v3 * v3));
        const float rstd = 1.0f / sqrtf(ss * (1.0f / 256) + EPS);
        u32x2 w; w.x = cvtpk(v0 * rstd * g4[0], v1 * rstd * g4[1]); w.y = cvtpk(v2 * rstd * g4[2], v3 * rstd * g4[3]);
        *(u32x2*)(cqn + (size_t)m * 256 + 4 * lane) = w;
    }
    {
        const float v0 = bflo(R.r_ckv), v1 = bfhi(R.r_ckv);
        const float ss = wave_sum(v0 * v0 + v1 * v1);
        const float rstd = 1.0f / sqrtf(ss * (1.0f / 128) + EPS);
        *(unsigned*)(ckvn + (size_t)m * 128 + 2 * lane) = cvtpk(v0 * rstd * g2[0], v1 * rstd * g2[1]);
    }
    if (lane < 8) {
        ROPE2(R.r_kr1, R.r_kr2, R.cs32, y1a, y1b, y2a, y2b)
        const unsigned w1 = cvtpk(y1a, y1b), w2 = cvtpk(y2a, y2b);
#pragma unroll
        for (int h = 0; h < 4; ++h) { *(unsigned*)(Kmla + (size_t)m * 384 + h * 96 + 64 + i16) = w1; *(unsigned*)(Kmla + (size_t)m * 384 + h * 96 + 80 + i16) = w2; }
    }
    {
        const int ch = lane >> 3;
        { ROPE2(R.dq1, R.dq2, R.cs32, y1a, y1b, y2a, y2b)
          bf16_t* q = pr + C_DQ + ch * 32 + i16; *(unsigned*)q = cvtpk(y1a * QS_DIFF, y1b * QS_DIFF); *(unsigned*)(q + 16) = cvtpk(y2a * QS_DIFF, y2b * QS_DIFF); }
        { ROPE2(R.dk1, R.dk2, R.cs32, y1a, y1b, y2a, y2b)
          bf16_t* k = pr + C_DK + ch * 32 + i16; *(unsigned*)k = cvtpk(y1a, y1b); *(unsigned*)(k + 16) = cvtpk(y2a, y2b); }
    }
#pragma unroll
    for (int rep = 0; rep < 2; ++rep) {
        const int ch = (lane + 64 * rep) >> 4;
        ROPE2(R.nq1[rep], R.nq2[rep], R.cs64, y1a, y1b, y2a, y2b)
        bf16_t* q = pr + C_NQ + ch * 64 + i32; *(unsigned*)q = cvtpk(y1a * QS_NSA, y1b * QS_NSA); *(unsigned*)(q + 32) = cvtpk(y2a * QS_NSA, y2b * QS_NSA);
    }
#pragma unroll
    for (int rep = 0; rep < 2; ++rep) {
        const int ch = (lane + 64 * rep) >> 4;
        if (ch < 6) {
            const int br = ch >> 1, g = ch & 1;
            ROPE2(R.nk1[rep], R.nk2[rep], R.cs64, y1a, y1b, y2a, y2b)
            bf16_t* k = pr + C_NKV + br * 256 + g * 64 + i32; *(unsigned*)k = cvtpk(y1a, y1b); *(unsigned*)(k + 32) = cvtpk(y2a, y2b);
            if (br == 0) {
                const size_t rowb = (size_t)(b * 2 + g) * 256;
                if (nc0 <= 254) { bf16_t* f = flatK + (rowb + nc0) * 2048 + l0 * 64 + i32; *(unsigned*)f = cvtpk(y1a + R.pk0a[0], y1b + R.pk0a[1]); *(unsigned*)(f + 32) = cvtpk(y2a + R.pk0b[0], y2b + R.pk0b[1]); }
                if (nc0 >= 1) { bf16_t* f = flatK + (rowb + nc0 - 1) * 2048 + l1 * 64 + i32; *(unsigned*)f = cvtpk(y1a + R.pk1a[0], y1b + R.pk1a[1]); *(unsigned*)(f + 32) = cvtpk(y2a + R.pk1b[0], y2b + R.pk1b[1]); }
            }
        }
    }
    {
        const float v0 = bflo(R.r_v), v1 = bfhi(R.r_v);
        const size_t rowb = (size_t)(b * 2 + vg) * 256;
        if (nc0 <= 254) *(unsigned*)(flatV + (rowb + nc0) * 2048 + l0 * 64 + vd) = cvtpk(v0 + R.pv0[0], v1 + R.pv0[1]);
        if (nc0 >= 1) *(unsigned*)(flatV + (rowb + nc0 - 1) * 2048 + l1 * 64 + vd) = cvtpk(v0 + R.pv1[0], v1 + R.pv1[1]);
    }
    if (lane < 24) { const float z = bf2f(R.r_gate) + gb; gates[(size_t)m * 24 + lane] = 1.0f / (1.0f + __expf(-z)); }
}
#undef ROPE2
__device__ __forceinline__ void post_phase(bf16_t* __restrict__ P, const float* __restrict__ tab32, const float* __restrict__ tab64,
        const float* __restrict__ gq, const float* __restrict__ gkv, const float* __restrict__ gate_b, const float* __restrict__ posK, const float* __restrict__ posV,
        bf16_t* __restrict__ cqn, bf16_t* __restrict__ ckvn, bf16_t* __restrict__ Kmla, bf16_t* __restrict__ flatK, bf16_t* __restrict__ flatV, float* __restrict__ gates,
        int gw, int NGW, int lane) {
    const f32x4 g4 = ((const f32x4*)gq)[lane];
    const f32x2 g2 = ((const f32x2*)gkv)[lane];
    const float gb = gate_b[lane < 24 ? lane : 23];
    if (gw >= MROWS) return;
    PostRegs Rc, Rn;
    post_load(Rc, gw, lane, P, tab32, tab64, posK, posV);
    for (int m = gw; m < MROWS; m += NGW) {
        const int mn = m + NGW;
        if (mn < MROWS) post_load(Rn, mn, lane, P, tab32, tab64, posK, posV);
        post_store(Rc, m, lane, P, g4, g2, gb, cqn, ckvn, Kmla, flatK, flatV, gates);
        Rc = Rn;
    }
}

__device__ __forceinline__ v4i16_t tr_read(LAS unsigned char* p) { return __builtin_amdgcn_ds_read_tr16_b64_v4i16((LAS v4i16_t*)p); }

template <int DQK, int MODE>
__device__ __forceinline__ void attn_pass(LAS unsigned char* lds, const bf16_t* __restrict__ Qp, int qs, const bf16_t* __restrict__ Kp, int ks,
                                          const bf16_t* __restrict__ Vp, int vs, int t0, const unsigned long long* __restrict__ selp, f32x16 (&o)[2], float& linv, const int wave0) {
    constexpr int NDS = DQK / 16, CPR = DQK / 8, KSL = CPR * 1024, VSL = 8192, SLOT = KSL + VSL, NKW = (CPR > 8) ? 2 : 1;
    static_assert(3 * SLOT <= 65536, "ring fits below the accumulator park area");
    const int tid = make_tid(wave0), lane = tid & 63, r32 = lane & 31, hi = lane >> 5;
    const int wid = wave0;
    const int tw0 = t0 + 32 * wid, tq = tw0 + r32;
    bf16x8 qf[NDS];
#pragma unroll
    for (int ds = 0; ds < NDS; ++ds) qf[ds] = *(const bf16x8*)(Qp + (size_t)tq * qs + 16 * ds + 8 * hi);
    int kt_lo = 0; const int kt_hi = (t0 >> 6) + 3;
    if (MODE == 1) { const int lo = t0 - 511; kt_lo = lo > 0 ? (lo >> 6) : 0; }
    unsigned long long selm = 0ull; if (MODE == 2) selm = selp[tq];
    const int kc0 = wid % CPR, kc1 = (8 + (wid & 3)) % CPR;
    const bf16_t* ksrc0 = Kp + (size_t)lane * ks + kc0 * 8;
    const bf16_t* ksrc1 = Kp + (size_t)lane * ks + kc1 * 8;
    const bf16_t* vsrc = Vp + (size_t)(16 * (wid & 3) + (lane >> 2)) * vs + (wid >> 2) * 32 + (lane & 3) * 8;
#define AT_CL(t) ((t) < kt_hi ? (t) : kt_hi)
#define AT_DMAK(t) do { const int t_ = AT_CL(t); LAS unsigned char* d_ = lds + (t_ % 3) * SLOT; \
        __builtin_amdgcn_global_load_lds((const GAS unsigned*)(ksrc0 + (size_t)t_ * 64 * ks), (LAS unsigned*)(d_ + kc0 * 1024), 16, 0, 0); \
        if (NKW > 1) __builtin_amdgcn_global_load_lds((const GAS unsigned*)(ksrc1 + (size_t)t_ * 64 * ks), (LAS unsigned*)(d_ + kc1 * 1024), 16, 0, 0); } while (0)
#define AT_DMAV(t) do { const int t_ = AT_CL(t); LAS unsigned char* d_ = lds + (t_ % 3) * SLOT + KSL; \
        __builtin_amdgcn_global_load_lds((const GAS unsigned*)(vsrc + (size_t)t_ * 64 * vs), (LAS unsigned*)(d_ + wid * 1024), 16, 0, 0); } while (0)
#define AT_WAITBAR(N) asm volatile("s_waitcnt vmcnt(" #N ") lgkmcnt(0)\n\ts_barrier" ::: "memory")
#define AT_KFRAG(t) do { \
        LAS unsigned char* Kb_ = lds + ((t) % 3) * SLOT + hi * 1024 + r32 * 16; \
        _Pragma("unroll") for (int ds = 0; ds < NDS; ++ds) { kf[2 * ds] = *(LAS bf16x8*)(Kb_ + ds * 2048); kf[2 * ds + 1] = *(LAS bf16x8*)(Kb_ + ds * 2048 + 512); } } while (0)
#define AT_QKM(P0, P1, BIAS) do { \
        P0 = __builtin_amdgcn_mfma_f32_32x32x16_bf16(kf[0], qf[0], BIAS, 0, 0, 0); \
        P1 = __builtin_amdgcn_mfma_f32_32x32x16_bf16(kf[1], qf[0], BIAS, 0, 0, 0); \
        _Pragma("unroll") for (int ds = 1; ds < NDS; ++ds) { \
            P0 = __builtin_amdgcn_mfma_f32_32x32x16_bf16(kf[2 * ds], qf[ds], P0, 0, 0, 0); \
            P1 = __builtin_amdgcn_mfma_f32_32x32x16_bf16(kf[2 * ds + 1], qf[ds], P1, 0, 0, 0); } } while (0)
#define AT_BIAS(t) ((MODE == 2) ? ((((selm >> (t)) & 1ull) != 0ull) ? 0.f : -INFINITY) : 0.f)
#define AT_SPLAT(b) (f32x16){b, b, b, b, b, b, b, b, b, b, b, b, b, b, b, b}
    o[0] = f32x16{}; o[1] = f32x16{};
    float m_run = 0.f, l_run = 0.f; bool init = false;
    f32x16 negm = f32x16{}; asm volatile("" : "+v"(negm));
    f32x16 pa0 = f32x16{}, pa1 = f32x16{}, pb0 = f32x16{}, pb1 = f32x16{};
    bf16x8 kf[2 * NDS];
    AT_DMAK(kt_lo); AT_DMAV(kt_lo); AT_DMAK(kt_lo + 1); AT_DMAK(kt_lo + 2); AT_DMAV(kt_lo + 1);
    if (NKW > 1) AT_WAITBAR(3); else AT_WAITBAR(2);
    { AT_KFRAG(kt_lo); asm volatile("s_waitcnt lgkmcnt(0)\n\ts_barrier" ::: "memory");
      const float b_ = AT_BIAS(kt_lo); AT_QKM(pa0, pa1, AT_SPLAT(b_)); }
    const int vfo = ((lane >> 4) & 1) * 32 + (lane & 3) * 8 + (4 * hi + ((lane & 15) >> 2)) * 64;
#define AT_SB() __builtin_amdgcn_sched_barrier(0)
#define AT_VFR(dst, kk0) do { _Pragma("unroll") for (int kk = 0; kk < 2; ++kk) _Pragma("unroll") for (int dh = 0; dh < 2; ++dh) { \
            dst[(kk * 2 + dh) * 2] = tr_read(vb + dh * 4096 + ((kk0) + kk) * 1024); dst[(kk * 2 + dh) * 2 + 1] = tr_read(vb + dh * 4096 + ((kk0) + kk) * 1024 + 512); } } while (0)
#define AT_PV2(src, kk0) do { _Pragma("unroll") for (int kk = 0; kk < 2; ++kk) _Pragma("unroll") for (int dh = 0; dh < 2; ++dh) { \
            const v4i16_t lo = src[(kk * 2 + dh) * 2], hh = src[(kk * 2 + dh) * 2 + 1]; \
            const bf16x8 vf = {lo[0], lo[1], lo[2], lo[3], hh[0], hh[1], hh[2], hh[3]}; \
            o[dh] = __builtin_amdgcn_mfma_f32_32x32x16_bf16(vf, __builtin_bit_cast(bf16x8, pk[(kk0) + kk]), o[dh], 0, 0, 0); } } while (0)
#define AT_STEPF(PC0, PC1, PN0, PN1, kt) do { \
        AT_DMAK((kt) + 3); AT_DMAV((kt) + 2); \
        { bool need = (64 * (kt) + 63 > tw0); \
          if (MODE == 1) need = need || (64 * (kt) < tw0 + 31 - 511); \
          if (need) { \
              const int limh = tq - 64 * (kt) - 4 * hi; \
              const int lowh = limh - 512; \
              _Pragma("unroll") for (int r = 0; r < 16; ++r) { \
                  const int c_ = (r & 3) + 8 * (r >> 2); \
                  bool ok0 = (c_ <= limh), ok1 = (c_ + 32 <= limh); \
                  if (MODE == 1) { ok0 = ok0 && (c_ > lowh); ok1 = ok1 && (c_ + 32 > lowh); } \
                  PC0[r] = ok0 ? PC0[r] : -INFINITY; PC1[r] = ok1 ? PC1[r] : -INFINITY; } } } \
          \
        AT_KFRAG(AT_CL((kt) + 1)); \
        LAS unsigned char* vb = lds + ((kt) % 3) * SLOT + KSL + vfo; \
        asm volatile("s_nop 15\n\ts_nop 7" : "+v"(PC0), "+v"(PC1));        \
        float mx = max3f(PC0[0], PC1[0], PC0[1]), mxb = max3f(PC1[1], PC0[2], PC1[2]); \
        _Pragma("unroll") for (int r = 3; r < 15; r += 2) { mx = max3f(mx, PC0[r], PC1[r]); mxb = max3f(mxb, PC0[r + 1], PC1[r + 1]); } \
        mx = max3f(mx, PC0[15], PC1[15]); asm volatile("s_nop 1" : "+v"(mx), "+v"(mxb)); mx = fmaxf(mx, mxb); \
        mx = max32x(mx); \
        { const bool grow = init ? (mx > 8.0f) : (mx > -INFINITY);        \
          if (__any(grow)) { \
              const float dl = grow ? mx : 0.f; \
              init = init || grow; \
              m_run += dl; \
              _Pragma("unroll") for (int r = 0; r < 16; ++r) { PC0[r] -= dl; PC1[r] -= dl; } \
              const float alpha = __builtin_amdgcn_exp2f(-dl); \
              l_run *= alpha; \
              _Pragma("unroll") for (int r = 0; r < 16; ++r) { o[0][r] *= alpha; o[1][r] *= alpha; } \
              if (MODE != 2) { const float nm_ = -m_run; negm = AT_SPLAT(nm_); } } } \
        AT_SB(); \
          \
        if (MODE == 2) { const float b_ = (((selm >> AT_CL((kt) + 1)) & 1ull) != 0ull) ? -m_run : -INFINITY; AT_QKM(PN0, PN1, AT_SPLAT(b_)); } \
        else AT_QKM(PN0, PN1, negm); \
        v4i16_t va_[8], vb_[8]; \
        AT_VFR(va_, 0); \
        float ls = 0.f, lsb = 0.f; \
        _Pragma("unroll") for (int r = 0; r < 16; ++r) PC0[r] = __builtin_amdgcn_exp2f(PC0[r]); \
        asm volatile("s_nop 1" : "+v"(PC0));                                     \
        _Pragma("unroll") for (int r = 0; r < 16; r += 2) { ls = fadd_s(ls, PC0[r]); lsb = fadd_s(lsb, PC0[r + 1]); } \
        u32x4 pk[4]; \
        pk[0] = (u32x4){cvtpk(PC0[0], PC0[1]), cvtpk(PC0[2], PC0[3]), cvtpk(PC0[4], PC0[5]), cvtpk(PC0[6], PC0[7])}; \
        pk[1] = (u32x4){cvtpk(PC0[8], PC0[9]), cvtpk(PC0[10], PC0[11]), cvtpk(PC0[12], PC0[13]), cvtpk(PC0[14], PC0[15])}; \
        AT_SB(); \
          \
        AT_PV2(va_, 0); \
        AT_VFR(vb_, 2); \
        _Pragma("unroll") for (int r = 0; r < 16; ++r) PC1[r] = __builtin_amdgcn_exp2f(PC1[r]); \
        asm volatile("s_nop 1" : "+v"(PC1)); \
        _Pragma("unroll") for (int r = 0; r < 16; r += 2) { ls = fadd_s(ls, PC1[r]); lsb = fadd_s(lsb, PC1[r + 1]); } \
        pk[2] = (u32x4){cvtpk(PC1[0], PC1[1]), cvtpk(PC1[2], PC1[3]), cvtpk(PC1[4], PC1[5]), cvtpk(PC1[6], PC1[7])}; \
        pk[3] = (u32x4){cvtpk(PC1[8], PC1[9]), cvtpk(PC1[10], PC1[11]), cvtpk(PC1[12], PC1[13]), cvtpk(PC1[14], PC1[15])}; \
        asm volatile("s_nop 0" : "+v"(ls), "+v"(lsb)); \
        l_run += ls + lsb; \
        AT_SB(); \
          \
        AT_PV2(vb_, 2); \
        if (NKW > 1) AT_WAITBAR(3); else AT_WAITBAR(2); } while (0)
    for (int kt = kt_lo; kt <= kt_hi; kt += 2) {
        AT_STEPF(pa0, pa1, pb0, pb1, kt);
        if (kt + 1 <= kt_hi) AT_STEPF(pb0, pb1, pa0, pa1, kt + 1);
    }
    AT_WAITBAR(0);
#undef AT_STEPF
#undef AT_SB
#undef AT_VFR
#undef AT_PV2
#undef AT_KFRAG
#undef AT_QKM
#undef AT_BIAS
#undef AT_SPLAT
#undef AT_DMAK
#undef AT_DMAV
#undef AT_WAITBAR
#undef AT_CL
    const float lt = sum32x(l_run);
    linv = lt > 0.f ? 1.0f / lt : 0.f;
}

constexpr int OSAVE_OFF = 65536;
__device__ __forceinline__ void osave(LAS unsigned char* lds, int tid, const f32x16 (&o)[2], float sc) {
    LAS float* p = (LAS float*)(lds + OSAVE_OFF) + tid;
#pragma unroll
    for (int i = 0; i < 16; ++i) { p[i * 512] = o[0][i] * sc; p[(16 + i) * 512] = o[1][i] * sc; }
}
__device__ __forceinline__ float oload(LAS unsigned char* lds, int tid, int i) { return ((LAS float*)(lds + OSAVE_OFF) + tid)[i * 512]; }
__device__ __forceinline__ void store_o_bf16(bf16_t* dst, const f32x16 (&o)[2], int hi) {
#pragma unroll
    for (int dh = 0; dh < 2; ++dh)
#pragma unroll
        for (int ap = 0; ap < 2; ++ap) {
            const int a0 = 2 * ap, a1 = a0 + 1;
            unsigned x0 = cvtpk(o[dh][4 * a0], o[dh][4 * a0 + 1]), x1 = cvtpk(o[dh][4 * a0 + 2], o[dh][4 * a0 + 3]);
            unsigned y0 = cvtpk(o[dh][4 * a1], o[dh][4 * a1 + 1]), y1 = cvtpk(o[dh][4 * a1 + 2], o[dh][4 * a1 + 3]);
            const auto r0 = __builtin_amdgcn_permlane32_swap(x0, y0, false, false);
            const auto r1 = __builtin_amdgcn_permlane32_swap(x1, y1, false, false);
            const u32x4 w = {r0[0], r1[0], r0[1], r1[1]};
            *(u32x4*)(dst + 32 * dh + 8 * (hi ? a1 : a0)) = w;
        }
}

__device__ __forceinline__ void attn_phase(LAS unsigned char* lds, int* counter, const bf16_t* __restrict__ P, const bf16_t* __restrict__ Qm, const bf16_t* __restrict__ Kmla,
        const bf16_t* __restrict__ Vmla, const unsigned long long* __restrict__ mask, const bf16_t* __restrict__ ocmp, const float* __restrict__ gates,
        const float* __restrict__ dng, float lam, float lam_init, bf16_t* __restrict__ Omix, const int wave0) {
    LAS int* sunit = (LAS int*)(lds + MISC_OFF);
    const int wid = wave0;
    const int x0 = (int)((unsigned)__builtin_amdgcn_s_getreg((3 << 11) | 20) & 7u);
#pragma nounroll
    for (int xi = 0; xi < 8; ++xi) {
    const int bq = (x0 + xi) & 7;
    for (;;) {
        const int tid = make_tid(wave0), lane = tid & 63, r32 = lane & 31, hi = lane >> 5;
        __syncthreads();
        if (tid == 0) *sunit = atomicAdd(counter + bq, 1);
        __syncthreads();
        const int u = __builtin_amdgcn_readfirstlane(*sunit);
        if (u >= 256) break;
        int r, qb;
        if (u < 128) { qb = 15 - ((u & 63) >> 2); r = 64 + bq * 8 + (u >> 6) * 4 + (u & 3); }
        else if (u < 192) { const int v_ = u - 128; qb = 15 - ((v_ & 31) >> 1); r = 32 + bq * 4 + (v_ >> 5) * 2 + (v_ & 1); }
        else { const int v_ = u - 192; qb = 15 - ((v_ & 31) >> 1); r = bq * 4 + (v_ >> 5) * 2 + (v_ & 1); }
        const int t0 = qb * 256, tq = t0 + 32 * wid + r32;
        f32x16 o[2]; float linv;
        if (r < 32) {
            const int b = r >> 2, h = r & 3;
            const bf16_t* Pb = P + (size_t)b * SEQ * NPJ;
            attn_pass<32, 0>(lds, Pb + C_DQ + (2 * h) * 32, NPJ, Pb + C_DK + (2 * h) * 32, NPJ, Pb + C_DV + h * 64, NPJ, t0, nullptr, o, linv, wave0);
            osave(lds, tid, o, linv);
            attn_pass<32, 0>(lds, Pb + C_DQ + (2 * h + 1) * 32, NPJ, Pb + C_DK + (2 * h + 1) * 32, NPJ, Pb + C_DV + h * 64, NPJ, t0, nullptr, o, linv, wave0);
            const float l2 = lam * linv; float ss = 0.f;
#pragma unroll
            for (int i = 0; i < 16; ++i) { o[0][i] = oload(lds, tid, i) - l2 * o[0][i]; o[1][i] = oload(lds, tid, 16 + i) - l2 * o[1][i]; ss += o[0][i] * o[0][i] + o[1][i] * o[1][i]; }
            ss = sum32x(ss);
            const float rs = (1.0f / sqrtf(ss * (1.0f / 64) + EPS)) * (1.0f - lam_init);
#pragma unroll
            for (int dh = 0; dh < 2; ++dh)
#pragma unroll
                for (int a = 0; a < 4; ++a) { const f32x4 g4 = *(const f32x4*)(dng + 32 * dh + 8 * a + 4 * hi);
#pragma unroll
                    for (int j = 0; j < 4; ++j) o[dh][4 * a + j] *= rs * g4[j]; }
            store_o_bf16(Omix + (size_t)(b * SEQ + tq) * DM + 256 + h * 64, o, hi);
        } else if (r < 64) {
            const int b = (r - 32) >> 2, h = (r - 32) & 3;
            const size_t rb = (size_t)b * SEQ;
            attn_pass<96, 0>(lds, Qm + rb * 384 + h * 96, 384, Kmla + rb * 384 + h * 96, 384, Vmla + rb * 256 + h * 64, 256, t0, nullptr, o, linv, wave0);
#pragma unroll
            for (int i = 0; i < 16; ++i) { o[0][i] *= linv; o[1][i] *= linv; }
            store_o_bf16(Omix + (rb + tq) * DM + h * 64, o, hi);
        } else {
            const int b = (r - 64) >> 3, head = (r - 64) & 7, g = head >> 2;
            const bf16_t* Pb = P + (size_t)b * SEQ * NPJ;
            attn_pass<64, 2>(lds, Pb + C_NQ + head * 64, NPJ, Pb + C_NKV + 256 + g * 64, NPJ, Pb + C_NKV + 384 + g * 64, NPJ, t0, mask + (size_t)(b * 2 + g) * SEQ, o, linv, wave0);
            const size_t row = (size_t)b * SEQ + tq;
            osave(lds, tid, o, linv * gates[row * 24 + head * 3 + 1]);
            attn_pass<64, 1>(lds, Pb + C_NQ + head * 64, NPJ, Pb + C_NKV + 512 + g * 64, NPJ, Pb + C_NKV + 640 + g * 64, NPJ, t0, nullptr, o, linv, wave0);
            const float g0 = gates[row * 24 + head * 3 + 0], sc2 = linv * gates[row * 24 + head * 3 + 2];
            const bf16_t* oc = ocmp + row * 512 + head * 64;
#pragma unroll
            for (int dh = 0; dh < 2; ++dh)
#pragma unroll
                for (int a = 0; a < 4; ++a) {
                    const u32x2 raw = *(const u32x2*)(oc + 32 * dh + 8 * a + 4 * hi);
                    const float c0 = __uint_as_float(raw.x << 16), c1 = __uint_as_float(raw.x & 0xffff0000u), c2 = __uint_as_float(raw.y << 16), c3 = __uint_as_float(raw.y & 0xffff0000u);
                    o[dh][4 * a + 0] = o[dh][4 * a + 0] * sc2 + oload(lds, tid, 16 * dh + 4 * a + 0) + g0 * c0;
                    o[dh][4 * a + 1] = o[dh][4 * a + 1] * sc2 + oload(lds, tid, 16 * dh + 4 * a + 1) + g0 * c1;
                    o[dh][4 * a + 2] = o[dh][4 * a + 2] * sc2 + oload(lds, tid, 16 * dh + 4 * a + 2) + g0 * c2;
                    o[dh][4 * a + 3] = o[dh][4 * a + 3] * sc2 + oload(lds, tid, 16 * dh + 4 * a + 3) + g0 * c3;
                }
            store_o_bf16(Omix + row * DM + 512 + head * 64, o, hi);
        }
    }
    }
}

__device__ __forceinline__ void cmp_phase(LAS unsigned char* lds, const bf16_t* __restrict__ P, const bf16_t* __restrict__ Kc, const bf16_t* __restrict__ Vc,
                                          bf16_t* __restrict__ ocmp, unsigned long long* __restrict__ mask, int G, const int wave0) {
    constexpr int KSTR = 144, VOFFC = 256 * KSTR;
    const int wid = wave0;
    for (int unit = opaque_bid(); unit < 256; unit += G) {
        const int tid = make_tid(wave0), lane = tid & 63, r32 = lane & 31, hi = lane >> 5;
        const int b = unit >> 5, g = (unit >> 4) & 1, kq = (unit >> 1) & 7, hq = unit & 1, bg = b * 2 + g;
        const int qb = (wid < 4) ? (15 - kq) : kq;
        __syncthreads();
#pragma unroll
        for (int i = 0; i < 4; ++i) {
            const int c = tid + 512 * i, row = c >> 3, ch = c & 7;
            const u32x4 kv = *(const u32x4*)(Kc + (size_t)(bg * 256 + row) * 64 + ch * 8);
            const u32x4 vv = *(const u32x4*)(Vc + (size_t)(bg * 256 + row) * 64 + ch * 8);
            *(LAS u32x4*)(lds + row * KSTR + ch * 16) = kv;
            *(LAS u32x4*)(lds + VOFFC + (ch >> 2) * 16384 + row * 64 + (ch & 3) * 16) = vv;
        }
        __syncthreads();
        const int tw0 = qb * 256 + hq * 128 + 32 * (wid & 3), tq = tw0 + r32;
        const int nch = ((tw0 >> 4) >> 6) + 1;
        const size_t row = (size_t)b * SEQ + tq;
        LAS float* mi = (LAS float*)(lds + MI_OFF + wid * 1024);
        LAS float* sc = (LAS float*)(lds + SC_OFF + wid * (32 * 65 * 4) + r32 * (65 * 4));
#define CMP_QK(c_) \
                f32x16 p0 = f32x16{}, p1 = f32x16{}; \
                _Pragma("unroll") for (int ds = 0; ds < 4; ++ds) { \
                    const bf16x8 ka = *(LAS bf16x8*)(lds + (64 * (c_) + r32) * KSTR + ds * 32 + hi * 16); \
                    const bf16x8 kb = *(LAS bf16x8*)(lds + (64 * (c_) + 32 + r32) * KSTR + ds * 32 + hi * 16); \
                    p0 = __builtin_amdgcn_mfma_f32_32x32x16_bf16(ka, qf[ds], p0, 0, 0, 0); \
                    p1 = __builtin_amdgcn_mfma_f32_32x32x16_bf16(kb, qf[ds], p1, 0, 0, 0); }
#pragma nounroll
        for (int hh = 0; hh < 4; ++hh) {
            const int head = 4 * g + hh;
            bf16x8 qf[4];
#pragma unroll
            for (int ds = 0; ds < 4; ++ds) qf[ds] = *(const bf16x8*)(P + row * NPJ + C_NQ + head * 64 + 16 * ds + 8 * hi);
            float m_run = -1e30f, l_run = 0.f;
#pragma nounroll
            for (int c = 0; c < nch; ++c) {
                CMP_QK(c)
                if (16 * (64 * c + 63) + 31 > tw0) {
#pragma unroll
                    for (int r = 0; r < 16; ++r) {
                        const int nc = 64 * c + crow(r, hi);
                        p0[r] = (16 * nc + 31 <= tq) ? p0[r] : -INFINITY; p1[r] = (16 * (nc + 32) + 31 <= tq) ? p1[r] : -INFINITY;
                    }
                }
                asm volatile("s_nop 15\n\ts_nop 7" : "+v"(p0), "+v"(p1));
                float mx = max3f(p0[0], p1[0], p0[1]);
#pragma unroll
                for (int r = 1; r < 16; ++r) mx = max3f(mx, p0[r], p1[r]);
                asm volatile("s_nop 1" : "+v"(mx));
                mx = fmaxf(mx, mx);
                mx = max32x(mx);
                const float m_new = fmaxf(m_run, mx);
                float ls = 0.f;
#pragma unroll
                for (int r = 0; r < 16; ++r) ls += __builtin_amdgcn_exp2f(p0[r] - m_new) + __builtin_amdgcn_exp2f(p1[r] - m_new);
                l_run = l_run * __builtin_amdgcn_exp2f(m_run - m_new) + ls;
                m_run = m_new;
            }
            const float lt = sum32x(l_run);
            const float inv = lt > 0.f ? 1.0f / lt : 0.f;
            if (hi == 0) { mi[(hh * 32 + r32) * 2] = m_run; mi[(hh * 32 + r32) * 2 + 1] = inv; }
            f32x16 o[2]; o[0] = f32x16{}; o[1] = f32x16{};
#pragma nounroll
            for (int c = 0; c < nch; ++c) {
                CMP_QK(c)
                if (16 * (64 * c + 63) + 31 > tw0) {
#pragma unroll
                    for (int r = 0; r < 16; ++r) {
                        const int nc = 64 * c + crow(r, hi);
                        p0[r] = (16 * nc + 31 <= tq) ? p0[r] : -INFINITY; p1[r] = (16 * (nc + 32) + 31 <= tq) ? p1[r] : -INFINITY;
                    }
                }
#pragma unroll
                for (int r = 0; r < 16; ++r) { p0[r] = __builtin_amdgcn_exp2f(p0[r] - m_run) * inv; p1[r] = __builtin_amdgcn_exp2f(p1[r] - m_run) * inv; }
                u32x4 pk[4];
                pk[0] = (u32x4){cvtpk(p0[0], p0[1]), cvtpk(p0[2], p0[3]), cvtpk(p0[4], p0[5]), cvtpk(p0[6], p0[7])};
                pk[1] = (u32x4){cvtpk(p0[8], p0[9]), cvtpk(p0[10], p0[11]), cvtpk(p0[12], p0[13]), cvtpk(p0[14], p0[15])};
                pk[2] = (u32x4){cvtpk(p1[0], p1[1]), cvtpk(p1[2], p1[3]), cvtpk(p1[4], p1[5]), cvtpk(p1[6], p1[7])};
                pk[3] = (u32x4){cvtpk(p1[8], p1[9]), cvtpk(p1[10], p1[11]), cvtpk(p1[12], p1[13]), cvtpk(p1[14], p1[15])};
                LAS unsigned char* vb = lds + VOFFC + (64 * c) * 64 + ((lane >> 4) & 1) * 32 + (lane & 3) * 8 + (4 * hi + ((lane & 15) >> 2)) * 64;
#pragma unroll
                for (int dh = 0; dh < 2; ++dh)
#pragma unroll
                    for (int kk = 0; kk < 4; ++kk) {
                        const v4i16_t lo = tr_read(vb + dh * 16384 + kk * 1024), hh2 = tr_read(vb + dh * 16384 + kk * 1024 + 512);
                        const bf16x8 vf = {lo[0], lo[1], lo[2], lo[3], hh2[0], hh2[1], hh2[2], hh2[3]};
                        o[dh] = __builtin_amdgcn_mfma_f32_32x32x16_bf16(vf, __builtin_bit_cast(bf16x8, pk[kk]), o[dh], 0, 0, 0);
                    }
            }
            store_o_bf16(ocmp + row * 512 + head * 64, o, hi);
            asm volatile("" ::: "memory");
        }
        const int cblk = tq >> 6;
        float carry = 0.f;
#pragma nounroll
        for (int c = 0; c < 4; ++c) {
            float A8[8], B8[8];
#pragma unroll
            for (int k = 0; k < 8; ++k) { A8[k] = 0.f; B8[k] = 0.f; }
            if (c < nch) {
#pragma nounroll
                for (int hh = 0; hh < 4; ++hh) {
                    const int head = 4 * g + hh;
                    bf16x8 qf[4];
#pragma unroll
                    for (int ds = 0; ds < 4; ++ds) qf[ds] = *(const bf16x8*)(P + row * NPJ + C_NQ + head * 64 + 16 * ds + 8 * hi);
                    CMP_QK(c)
                    const float m_h = mi[(hh * 32 + r32) * 2], i_h = mi[(hh * 32 + r32) * 2 + 1];
                    if (16 * (64 * c + 63) + 31 > tw0) {
#pragma unroll
                        for (int r = 0; r < 16; ++r) {
                            const int nc = 64 * c + crow(r, hi);
                            p0[r] = (16 * nc + 31 <= tq) ? p0[r] : -INFINITY; p1[r] = (16 * (nc + 32) + 31 <= tq) ? p1[r] : -INFINITY;
                        }
                    }
#pragma unroll
                    for (int r = 0; r < 16; ++r) { p0[r] = __builtin_amdgcn_exp2f(p0[r] - m_h) * i_h; p1[r] = __builtin_amdgcn_exp2f(p1[r] - m_h) * i_h; }
#pragma unroll
                    for (int k = 0; k < 4; ++k) {
                        A8[k] += p0[4 * k] + 2.0f * (p0[4 * k + 1] + p0[4 * k + 2] + p0[4 * k + 3]); B8[k] += p0[4 * k];
                        A8[4 + k] += p1[4 * k] + 2.0f * (p1[4 * k + 1] + p1[4 * k + 2] + p1[4 * k + 3]); B8[4 + k] += p1[4 * k];
                    }
                }
            }
            float pa[8];
#pragma unroll
            for (int k = 0; k < 8; ++k) pa[k] = partner32(A8[k], hi);
#pragma unroll
            for (int k = 0; k < 8; ++k) {
                const int i = 8 * c + k, j = 2 * i + hi;
                const float ap = hi ? pa[k] : (k > 0 ? pa[k - 1] : carry);
                const float ps = B8[k] + ap;
                const bool forced = (j == 0) || (j == cblk) || (j == cblk - 1);
                sc[j] = (j > cblk) ? -1.0f : (ps + (forced ? 1e4f : 0.f));
            }
            carry = pa[7];
        }
#undef CMP_QK
        asm volatile("" ::: "memory");
        {
            float s[32];
#pragma unroll
            for (int i = 0; i < 32; ++i) s[i] = sc[2 * i + hi];
            int rank[32];
#pragma unroll
            for (int i = 0; i < 32; ++i) rank[i] = 0;
            const int kmax = ((tw0 + 31) >> 6) + 1;
#pragma nounroll
            for (int k = 0; k < kmax; ++k) {
                const float sk = sc[k];
                const int kk = k - hi;
#pragma unroll
                for (int i = 0; i < 32; ++i) rank[i] += ((sk > s[i]) || ((sk == s[i]) && (kk < 2 * i))) ? 1 : 0;
            }
            unsigned mlo = 0u, mhi = 0u;
#pragma unroll
            for (int i = 0; i < 32; ++i) {
                const unsigned bit = (rank[i] < 16) ? 1u : 0u;
                if (i < 16) mlo |= bit << (2 * i + hi); else mhi |= bit << (2 * (i - 16) + hi);
            }
            mlo = or32x(mlo); mhi = or32x(mhi);
            if (hi == 0) mask[(size_t)bg * SEQ + tq] = ((unsigned long long)mhi << 32) | (unsigned long long)mlo;
        }
    }
}

typedef unsigned short bf16;
#define XB_TMO      128
#define XB_XCNT(j)  (256  + 64 * (j))
#define XB_XSUB(j)  (1280 + 64 * (j))
#define XB_XGEN(j)  (2304 + 64 * (j))
#define XB_TOP      3328
#define XB_TOPGEN   3392
#define XCD_BAR_WORDS 3456
#define XB_SPIN_CAP (1u << 18)

__device__ __forceinline__ unsigned xb_ld(unsigned* p)              { return __hip_atomic_load(p, __ATOMIC_RELAXED, __HIP_MEMORY_SCOPE_AGENT); }
__device__ __forceinline__ unsigned xb_add(unsigned* p, unsigned v) { return __hip_atomic_fetch_add(p, v, __ATOMIC_RELAXED, __HIP_MEMORY_SCOPE_AGENT); }
__device__ __forceinline__ unsigned xb_xcc_id() { return (unsigned)__builtin_amdgcn_s_getreg((3 << 11) | 20) & 0xFu; }
#define XB_SPIN(cond, bar) do { unsigned _sp = 0; while (cond) { __builtin_amdgcn_s_sleep(1); \
    if ((++_sp & 255u) == 0u) { if (xb_ld(&(bar)[XB_TMO])) break; if (_sp > XB_SPIN_CAP) { atomicAdd(&(bar)[XB_TMO], 1u); break; } } } } while (0)

struct XcdBarrier {
    unsigned* bar; unsigned x;
    volatile LAS unsigned* st;
};

__device__ __forceinline__ XcdBarrier xcd_barrier_post(unsigned* bar, volatile LAS unsigned* st) {
    XcdBarrier b; b.bar = bar; b.x = xb_xcc_id(); b.st = st;
    if (threadIdx.x == 0) (void)xb_add(&bar[XB_XCNT(b.x)], 1u);
    return b;
}
__device__ __forceinline__ void xcd_barrier_complete(unsigned* bar, unsigned x, unsigned& nloc, unsigned& nx) {
    const unsigned G = gridDim.x * gridDim.y * gridDim.z;
    unsigned sum, cnt, mine, sp = 0u;
    for (;;) {
        sum = 0u; cnt = 0u; mine = 0u;
#pragma unroll
        for (unsigned j = 0; j < 16; ++j) { const unsigned c = xb_ld(&bar[XB_XCNT(j)]); sum += c; cnt += (c > 0u) ? 1u : 0u; mine = (j == x) ? c : mine; }
        if (sum == G) break;
        __builtin_amdgcn_s_sleep(1);
        if ((++sp & 255u) == 0u) { if (xb_ld(&bar[XB_TMO])) break; if (sp > XB_SPIN_CAP) { atomicAdd(&bar[XB_TMO], 1u); break; } }
    }
    nloc = mine > 0u ? mine : 1u; nx = cnt > 0u ? cnt : 1u;
}

__device__ __forceinline__ void xcd_barrier(const XcdBarrier& b) {
    asm volatile("s_waitcnt vmcnt(0)" ::: "memory");
    __syncthreads();
    if (threadIdx.x == 0) {
        unsigned* bar = b.bar;
        __builtin_amdgcn_s_waitcnt(0);
        unsigned nloc = b.st[0], nx = b.st[1];
        if (nloc == 0u) { xcd_barrier_complete(bar, b.x, nloc, nx); b.st[0] = nloc; b.st[1] = nx; }
        const unsigned old = xb_add(&bar[XB_XSUB(b.x)], 1u);
        const unsigned gen = old / nloc;
        if (old + 1u == (gen + 1u) * nloc) {
            __builtin_amdgcn_fence(__ATOMIC_RELEASE, "agent");
            asm volatile("s_waitcnt vmcnt(0)" ::: "memory");
            const unsigned og = xb_add(&bar[XB_TOP], 1u);
            const unsigned tg = og / nx;
            if (og + 1u == (tg + 1u) * nx) xb_add(&bar[XB_TOPGEN], 1u);
            else XB_SPIN(xb_ld(&bar[XB_TOPGEN]) == tg, bar);
            __builtin_amdgcn_fence(__ATOMIC_ACQUIRE, "agent");
            xb_add(&bar[XB_XGEN(b.x)], 1u);
            asm volatile("s_waitcnt vmcnt(0)" ::: "memory");
        } else {
            XB_SPIN(xb_ld(&bar[XB_XGEN(b.x)]) == gen, bar);
            __builtin_amdgcn_fence(__ATOMIC_ACQUIRE, "agent");
            asm volatile("s_waitcnt vmcnt(0)" ::: "memory");
        }
    }
    __syncthreads();
}

__device__ __forceinline__ void convert_layer(int l, const float* w_gate, const float* w_up, const float* w_down, const float* ffn_g, const float* w_in, const float* mix_g,
                                              const float* w_out, const float* w_uq, const float* w_ukv, const float* w1, const float* w2,
                                              unsigned char* ws, LAS float* scr, int gw, int NGW, int lane) {
#pragma nounroll
    for (int f = 0; f < 2; ++f) {
        const int lf = l * 2 + f; const size_t wo = (size_t)lf * DM * FF;
        transpose_mat(w_gate + wo, DM, FF, FF, (bf16_t*)(ws + WS_WGU + lf * SZ_WGU), 256, 0, scr, gw, NGW, lane, ffn_g + (size_t)lf * DM);
        transpose_mat(w_up + wo, DM, FF, FF, (bf16_t*)(ws + WS_WGU + lf * SZ_WGU), 256, 128, scr, gw, NGW, lane, ffn_g + (size_t)lf * DM);
        transpose_mat(w_down + wo, FF, DM, DM, (bf16_t*)(ws + WS_WD + lf * SZ_WD), 128, 0, scr, gw, NGW, lane);
    }
    transpose_mat(w_in + (size_t)l * DM * NIN, DM, NIN, NPJ, (bf16_t*)(ws + WS_WIN + l * SZ_WIN), 128, 0, scr, gw, NGW, lane, mix_g + (size_t)l * DM);
    transpose_mat(w_out + (size_t)l * DM * DM, DM, DM, DM, (bf16_t*)(ws + WS_WOUT + l * SZ_WOUT), 128, 0, scr, (gw + 512) % NGW, NGW, lane);
    transpose_mat(w_uq + (size_t)l * 256 * 384, 256, 384, 512, (bf16_t*)(ws + WS_WUQ + l * SZ_WUQ), 128, 0, scr, (gw + 1024) % NGW, NGW, lane);
    transpose_mat(w_ukv + (size_t)l * 128 * 512, 128, 512, 512, (bf16_t*)(ws + WS_WUKV + l * SZ_WUKV), 128, 0, scr, (gw + 1200) % NGW, NGW, lane);
#pragma nounroll
    for (int kv = 0; kv < 2; ++kv) {
        transpose_mat(w1 + (size_t)(l * 2 + kv) * 2048 * 256, 2048, 256, 256, (bf16_t*)(ws + WS_W1 + (l * 2 + kv) * SZ_W1), 128, 0, scr, (gw + 1400 + 100 * kv) % NGW, NGW, lane);
        transpose_mat(w2 + (size_t)(l * 2 + kv) * 256 * 64, 256, 64, 256, (bf16_t*)(ws + WS_W2 + (l * 2 + kv) * SZ_W2), 128, 0, scr, (gw + 1600 + 40 * kv) % NGW, NGW, lane);
    }
}

struct KArgs { const float* in[20]; float* out; unsigned char* ws; };

#define PIN(i) ((const float*)(*(const GAS float* const*)(ws + WS_PTAB + 8 * (i))))
#define POUT ((float*)(*(GAS float* const*)(ws + WS_PTAB + 8 * 20)))
__device__ __forceinline__ GemmDesc make_gemm(int id, int l, int f, unsigned char* ws) {
    GemmDesc d; d.M = MROWS; d.rot = 0;
    d.e.kind = EK_BF16; d.e.fin = nullptr; d.e.fout = nullptr; d.e.o0 = nullptr; d.e.o1 = nullptr; d.e.aux = nullptr; d.e.ldc = 0; d.e.ncols = 0; d.e.flags = 0; d.e.coef = 0.f; d.e.pad = 0;
    bf16_t* hn = (bf16_t*)(ws + WS_HN); bf16_t* act = (bf16_t*)(ws + WS_ACT);
    switch (id) {
    case 0:
        d.A = f ? (const bf16_t*)(ws + WS_HN2) : hn; d.Bt = (const bf16_t*)(ws + WS_WGU + (size_t)(l * 2 + f) * SZ_WGU); d.N = 2 * FF; d.K = DM;
        d.e.kind = EK_ACT; d.e.o0 = (GAS bf16_t*)(act); d.e.ldc = FF; d.e.fin = (const GAS float*)(ws + WS_SS + (size_t)(l * 3 + (f ? 2 : 0)) * MROWS * 4); break;
    case 1:
        d.A = act; d.Bt = (const bf16_t*)(ws + WS_WD + (size_t)(l * 2 + f) * SZ_WD); d.N = DM; d.K = FF;
        d.e.kind = EK_RES; d.e.fin = (const GAS float*)((l == 0 && f == 0) ? PIN(0) : (const float*)POUT); d.e.fout = (GAS float*)(POUT); d.e.ldc = DM; d.e.coef = 0.5f;
        if (!(l == 1 && f == 1)) { d.e.flags = 2; d.e.o0 = (GAS bf16_t*)(hn); d.e.o1 = (GAS bf16_t*)(ws + WS_SS + (size_t)(f ? (l + 1) * 3 : l * 3 + 1) * MROWS * 4); }
        break;
    case 2:
        d.A = hn; d.Bt = (const bf16_t*)(ws + WS_WIN + (size_t)l * SZ_WIN); d.N = NPJ; d.K = DM;
        d.e.kind = EK_BF16; d.e.o0 = (GAS bf16_t*)(act); d.e.ldc = NPJ; d.e.ncols = NIN; d.e.flags = 4; d.e.fin = (const GAS float*)(ws + WS_SS + (size_t)(l * 3 + 1) * MROWS * 4); break;
    case 3:
        d.A = (const bf16_t*)(ws + WS_CQN); d.Bt = (const bf16_t*)(ws + WS_WUQ + (size_t)l * SZ_WUQ); d.N = 512; d.K = 256;
        d.e.kind = EK_QUP; d.e.o0 = (GAS bf16_t*)((bf16_t*)(ws + WS_QM)); d.e.aux = (const GAS float*)((const float*)(ws + WS_TAB32)); break;
    case 4:
        d.A = (const bf16_t*)(ws + WS_CKVN); d.Bt = (const bf16_t*)(ws + WS_WUKV + (size_t)l * SZ_WUKV); d.N = 512; d.K = 128;
        d.e.kind = EK_KVUP; d.e.o0 = (GAS bf16_t*)((bf16_t*)(ws + WS_KMLA)); d.e.o1 = (GAS bf16_t*)((bf16_t*)(ws + WS_VMLA)); break;
    case 5: case 6: {
        const int kv = id - 5;
        d.M = 4096; d.A = (const bf16_t*)(ws + (kv ? WS_FLATV : WS_FLATK)); d.Bt = (const bf16_t*)(ws + WS_W1 + (size_t)(l * 2 + kv) * SZ_W1); d.N = 256; d.K = 2048; d.rot = 16 + 16 * kv;
        d.e.kind = EK_BF16; d.e.o0 = (GAS bf16_t*)((bf16_t*)(ws + (kv ? WS_HIDV : WS_HIDK))); d.e.ldc = 256; d.e.ncols = 256; d.e.flags = 1; d.e.aux = (const GAS float*)(PIN(15) + (size_t)(l * 2 + kv) * 256); break; }
    case 7: case 8: {
        const int kv = id - 7;
        d.M = 4096; d.A = (const bf16_t*)(ws + (kv ? WS_HIDV : WS_HIDK)); d.Bt = (const bf16_t*)(ws + WS_W2 + (size_t)(l * 2 + kv) * SZ_W2); d.N = 256; d.K = 256; d.rot = 16 * kv;
        d.e.kind = EK_BF16; d.e.o0 = (GAS bf16_t*)((bf16_t*)(ws + (kv ? WS_VC : WS_KC))); d.e.ldc = 64; d.e.ncols = 64; break; }
    default:
        d.A = hn; d.Bt = (const bf16_t*)(ws + WS_WOUT + (size_t)l * SZ_WOUT); d.N = DM; d.K = DM;
        d.e.kind = EK_RES; d.e.fin = (const GAS float*)(POUT); d.e.fout = (GAS float*)(POUT); d.e.ldc = DM; d.e.coef = 1.0f;
        d.e.flags = 2; d.e.o0 = (GAS bf16_t*)(ws + WS_HN2); d.e.o1 = (GAS bf16_t*)(ws + WS_SS + (size_t)(l * 3 + 2) * MROWS * 4); break;
    }
    return d;
}

__global__ void __launch_bounds__(NTHR, 2) hymba_fwd(KArgs a) {
    extern __shared__ __attribute__((aligned(16))) unsigned char lds_raw[];
    LAS unsigned char* lds = (LAS unsigned char*)lds_raw;
    cg::grid_group grid = cg::this_grid();
    const int G = gridDim.x, NGW = G * 8;
    const int wave0 = __builtin_amdgcn_readfirstlane((int)threadIdx.x >> 6);
    if (threadIdx.x < 64) ((LAS unsigned*)(lds + MISC_OFF))[threadIdx.x] = 0u;
    __syncthreads();
    unsigned char* const ws0 = a.ws;

#ifdef PROBE_PRO2
#pragma nounroll
    for (int rep_ = 0; rep_ < 2; ++rep_)
#endif
    {
        const int tid = threadIdx.x, lane = tid & 63, wave = __builtin_amdgcn_readfirstlane(tid >> 6);
        const int gw = blockIdx.x * 8 + wave;
        unsigned char* ws = ws0;
        int* ctl = (int*)(ws + WS_CTL);
        float* ctlf = (float*)(ws + WS_CTL + 256);
        float* tab32 = (float*)(ws + WS_TAB32);
        float* tab64 = (float*)(ws + WS_TAB64);
        LAS float* scr = (LAS float*)(lds + wave * 16384);
        convert_layer(0, a.in[2], a.in[3], a.in[4], a.in[1], a.in[6], a.in[5], a.in[18], a.in[8], a.in[10], a.in[14], a.in[16], ws, scr, gw, NGW, lane);
        const int gtid = blockIdx.x * NTHR + tid, NT = G * NTHR;
        {
            bf16_t* hn = (bf16_t*)(ws + WS_HN); float* ss = (float*)(ws + WS_SS);
#pragma unroll 2
            for (int m = gw; m < MROWS; m += NGW) {
                const f32x4* xr = (const f32x4*)(a.in[0] + (size_t)m * DM) + lane; float sq = 0.f;
                u32x2* o8 = (u32x2*)(hn + (size_t)m * DM) + lane;
                f32x4 v[4];
#pragma unroll
                for (int j = 0; j < 4; ++j) v[j] = __builtin_nontemporal_load(xr + 64 * j);
#pragma unroll
                for (int j = 0; j < 4; ++j) { sq += (v[j][0] * v[j][0] + v[j][1] * v[j][1]) + (v[j][2] * v[j][2] + v[j][3] * v[j][3]); u32x2 w; w.x = cvtpk(v[j][0], v[j][1]); w.y = cvtpk(v[j][2], v[j][3]); o8[64 * j] = w; }
                sq = wave_sum(sq); if (lane == 0) ss[m] = sq;
            }
            for (int e = gtid; e < 5 * MROWS; e += NT) ss[MROWS + e] = 0.f;
        }
        for (int e = gtid; e < SEQ * 16; e += NT) {
            const int t = e >> 4, i = e & 15; double p = 1.0; for (int k = 0; k < i; ++k) p *= 0.5623413251903491;
            float c, s; sincos_acc((float)t * (float)p, c, s); tab32[2 * e] = c; tab32[2 * e + 1] = s;
        }
        for (int e = gtid; e < SEQ * 32; e += NT) {
            const int t = e >> 5, i = e & 31; double p = 1.0; for (int k = 0; k < i; ++k) p *= 0.7498942093324558;
            float c, s; sincos_acc((float)t * (float)p, c, s); tab64[2 * e] = c; tab64[2 * e + 1] = s;
        }
        for (int e = gtid; e < 2 * 16 * 256; e += NT) {
            const int which = e >> 12, r = (e >> 8) & 15, ch = e & 255;
            bf16_t* base = (bf16_t*)(ws + (which ? WS_FLATV : WS_FLATK)) + ((size_t)(r * 256 + 255)) * 2048 + ch * 8;
            *(u32x4*)base = (u32x4){0u, 0u, 0u, 0u};
        }
        if (blockIdx.x == 0) { unsigned* bw = (unsigned*)(ws + WS_BAR); for (int i = tid; i < XCD_BAR_WORDS; i += NTHR) bw[i] = 0u; }
        if (gtid == 0) {
            for (int i = 0; i < 20; ++i) *(const float**)(ws + WS_PTAB + 8 * i) = a.in[i];
            *(float**)(ws + WS_PTAB + 8 * 20) = a.out;
            EpiP* et = (EpiP*)(ws + WS_CTL + 1024);
            for (int l = 0; l < 2; ++l)
                for (int sl = 0; sl < 12; ++sl) { const GemmDesc d = make_gemm(sl < 10 ? sl : sl - 10, l, sl < 10 ? 0 : 1, ws); et[l * 12 + sl] = d.e; }
            for (int i = 0; i < 32; ++i) ctl[i] = 0;
            for (int l = 0; l < 2; ++l) {
                const float* lf = a.in[11] + l * 128; float s1 = 0.f, s2 = 0.f;
                for (int i = 0; i < 32; ++i) { s1 += lf[i] * lf[32 + i]; s2 += lf[64 + i] * lf[96 + i]; }
                const float li = (l == 0) ? 0.2f : 0.35550906759096934f;
                ctlf[2 * l] = expf(s1) - expf(s2) + li; ctlf[2 * l + 1] = li;
            }
        }
    }
    asm volatile("s_waitcnt vmcnt(0)" ::: "memory");
    grid.sync();
    (void)xcd_barrier_post((unsigned*)(ws0 + WS_BAR), (volatile LAS unsigned*)(lds + MISC_OFF) + 8);
#define GRID_BAR() do { XcdBarrier xb_; xb_.bar = (unsigned*)(ws0 + WS_BAR); xb_.x = xb_xcc_id(); xb_.st = (volatile LAS unsigned*)(lds + MISC_OFF) + 8; xcd_barrier(xb_); } while (0)

#ifdef PROBE_MASK
    int rep_ = 0;
#endif
#pragma nounroll
    for (int it = 0; it < 28; ++it) {
        GAS unsigned char* wsg_; asm volatile("s_mov_b64 %0, %1" : "=s"(wsg_) : "s"(ws0)); unsigned char* ws = (unsigned char*)wsg_;
        const int wave = wave0, bid = opaque_bid();
#define LANEV() (make_tid(wave0) & 63)
        const int gw = bid * 8 + wave;
        const int l = it / 14, s = it % 14;
        int gid0 = 0, ng = 0, f = 0;
        bf16_t* hn = (bf16_t*)(ws + WS_HN);
        bf16_t* P = (bf16_t*)(ws + WS_ACT);
#ifdef PROBE_NORM2
        if (s == 0) { norm_rows_bf16((l == 0) ? PIN(0) : POUT, PIN(1) + (size_t)(l * 2 + 0) * DM, hn, gw, NGW, LANEV()); GRID_BAR(); }
        else if (s == 3) { norm_rows_bf16(POUT, PIN(5) + (size_t)l * DM, hn, gw, NGW, LANEV()); GRID_BAR(); }
        else if (s == 11) { norm_rows_bf16(POUT, PIN(1) + (size_t)(l * 2 + 1) * DM, hn, gw, NGW, LANEV()); GRID_BAR(); }
#endif
#ifdef PROBE_CMP2
        if (s == 8) { cmp_phase(lds, P, (const bf16_t*)(ws + WS_KC), (const bf16_t*)(ws + WS_VC), (bf16_t*)(ws + WS_OCMP), (unsigned long long*)(ws + WS_MASK), G, wave0); GRID_BAR(); }
#endif
#ifdef PROBE_SYNC2
        GRID_BAR();
#endif
        if (s == 0 || s == 3 || s == 11) continue;
        if (s == 5) {
            post_phase(P, (const float*)(ws + WS_TAB32), (const float*)(ws + WS_TAB64), PIN(7) + l * 256, PIN(9) + l * 128, PIN(17) + l * 24, PIN(13) + (size_t)(l * 2 + 0) * 2048, PIN(13) + (size_t)(l * 2 + 1) * 2048,
                       (bf16_t*)(ws + WS_CQN), (bf16_t*)(ws + WS_CKVN), (bf16_t*)(ws + WS_KMLA), (bf16_t*)(ws + WS_FLATK), (bf16_t*)(ws + WS_FLATV), (float*)(ws + WS_GATES), gw, NGW, LANEV());
        }
        else if (s == 8) {
#ifndef NO_CMP
 cmp_phase(lds, P, (const bf16_t*)(ws + WS_KC), (const bf16_t*)(ws + WS_VC), (bf16_t*)(ws + WS_OCMP), (unsigned long long*)(ws + WS_MASK), G, wave0);
#endif
 }
        else if (s == 9) {
#ifndef NO_ATTN
#ifdef PROBE_ATTN2
            attn_phase(lds, (int*)(ws + WS_CTL) + 16 + 8 * l, P, (const bf16_t*)(ws + WS_QM), (const bf16_t*)(ws + WS_KMLA), (const bf16_t*)(ws + WS_VMLA), (const unsigned long long*)(ws + WS_MASK),
                       (const bf16_t*)(ws + WS_OCMP), (const float*)(ws + WS_GATES), PIN(12) + l * 64, ((const float*)(ws + WS_CTL + 256))[2 * l], ((const float*)(ws + WS_CTL + 256))[2 * l + 1], hn, wave0);
            GRID_BAR();
#endif
            attn_phase(lds, (int*)(ws + WS_CTL) + 8 * l, P, (const bf16_t*)(ws + WS_QM), (const bf16_t*)(ws + WS_KMLA), (const bf16_t*)(ws + WS_VMLA), (const unsigned long long*)(ws + WS_MASK),
                       (const bf16_t*)(ws + WS_OCMP), (const float*)(ws + WS_GATES), PIN(12) + l * 64, ((const float*)(ws + WS_CTL + 256))[2 * l], ((const float*)(ws + WS_CTL + 256))[2 * l + 1], hn, wave0);
#endif
        }
        else if (s == 1) { gid0 = 0; ng = 1; f = 0; }
#ifdef PROBE_UP2
        if (s == 1 || s == 12) ng = 2;
#endif
        else if (s == 2) { gid0 = 1; ng = 1; f = 0; }
        else if (s == 4) { gid0 = 2; ng = 1; }
        else if (s == 6) { gid0 = 3; ng = 4; }
        else if (s == 7) { gid0 = 7; ng = 2; }
        else if (s == 10) { gid0 = 9; ng = 1; }
        else if (s == 12) { gid0 = 0; ng = 1; f = 1; }
        else { gid0 = 1; ng = 1; f = 1; }
#pragma nounroll
        for (int j = 0; j < ng; ++j) {
#ifdef PROBE_UP2
            const GemmDesc d = make_gemm((s == 1 || s == 12) ? 0 : gid0 + j, l, f, ws);
#else
            const GemmDesc d = make_gemm(gid0 + j, l, f, ws);
#endif
            pg8::Gemm g{d.A, d.Bt, d.M, d.N, d.K};
#ifdef PROBE_UP2
            EpiGen eg; eg.p = (const EpiP*)(ws + WS_CTL + 1024) + (l * 12 + ((s == 1) ? 0 : (s == 12) ? 10 : ((f && gid0 + j < 2) ? 10 + gid0 + j : gid0 + j)));
#else
            const EpiP* egp = (const EpiP*)(ws + WS_CTL + 1024) + (l * 12 + ((f && gid0 + j < 2) ? 10 + gid0 + j : gid0 + j));
#endif
            pg8::StaticOrder S; S.init(d.M, d.N, G, (int)((bid + d.rot) % G));
#ifndef NO_GEMM
#define RUN_GEMM_K(KK) { pg8::Gemm gk{d.A, d.Bt, d.M, d.N, KK}; EpiGenT<false> eg; eg.p = egp; pg8::gemm_phase<EpiGenT<false>, pg8::StaticOrder, true, true>(lds, gk, S, eg, wave0); }
            if (d.K == 1024) { pg8::Gemm gk{d.A, d.Bt, d.M, d.N, 1024}; EpiGenT<true> eg; eg.p = egp; pg8::gemm_phase<EpiGenT<true>, pg8::StaticOrder, true, true>(lds, gk, S, eg, wave0); }
            else if (d.K == 2816) { pg8::Gemm gk{d.A, d.Bt, d.M, d.N, 2816}; EpiGenT<true> eg; eg.p = egp; pg8::gemm_phase<EpiGenT<true>, pg8::StaticOrder, true, true>(lds, gk, S, eg, wave0); }
            else if (d.K == 256) RUN_GEMM_K(256)
            else if (d.K == 128) RUN_GEMM_K(128)
            else RUN_GEMM_K(2048)
#undef RUN_GEMM_K
            (void)g;
#endif
        }
        const int cfirst = (G > 96) ? 48 : 0;
        if (s == 6 && l == 0 && bid >= cfirst) {
            const int lane_ = LANEV();
            convert_layer(1, PIN(2), PIN(3), PIN(4), PIN(1), PIN(6), PIN(5), PIN(18), PIN(8), PIN(10), PIN(14), PIN(16), ws, (LAS float*)(lds + wave * 16384), (bid - cfirst) * 8 + wave, (G - cfirst) * 8, lane_);
        }
        GRID_BAR();
#ifdef PROBE_MASK
#if PROBE_MASK == 0x10000
        if (s == 5 && !rep_) { rep_ = 1; it -= 2; } else if (s == 5) rep_ = 0;
#elif PROBE_MASK == 0x20000
        if (it == 2 && !rep_) { rep_ = 1; --it; }
#else
        if (((PROBE_MASK >> s) & 1) && !rep_) { rep_ = 1; --it; } else rep_ = 0;
#endif
#endif
    }
    { unsigned char* ws = ws0; const int tid = make_tid(wave0), lane = tid & 63; norm_rows_f32_inplace(POUT, PIN(19), blockIdx.x * 8 + wave0, NGW, lane); }
}

extern "C" void kernel_launch(void* const* d_in, const int* in_sizes, int n_in, void* d_out, int out_size, void* d_ws, size_t ws_size, hipStream_t stream) {
    static int grid = 0;
    if (grid == 0) {
        if (n_in != 20 || out_size != MROWS * DM || ws_size < WS_END) {
            fprintf(stderr, "kernel_launch: unexpected shapes (n_in %d, out %d, ws %zu, need %zu)\n", n_in, out_size, ws_size, (size_t)WS_END); grid = -1; return; }
        int dev = 0, cus = 0, per_cu = 0;
        if (hipGetDevice(&dev) != hipSuccess || hipDeviceGetAttribute(&cus, hipDeviceAttributeMultiprocessorCount, dev) != hipSuccess) { grid = -1; return; }
        if (hipFuncSetAttribute((const void*)hymba_fwd, hipFuncAttributeMaxDynamicSharedMemorySize, LDS_BYTES) != hipSuccess) { fprintf(stderr, "kernel_launch: hipFuncSetAttribute failed\n"); grid = -1; return; }
        if (hipOccupancyMaxActiveBlocksPerMultiprocessor(&per_cu, (const void*)hymba_fwd, NTHR, LDS_BYTES) != hipSuccess || per_cu < 1) {
            fprintf(stderr, "kernel_launch: occupancy query gave %d\n", per_cu); per_cu = 1; }
        (void)hipGetLastError();
        grid = cus * 1;
        if (per_cu < 1) grid = -1;
    }
    if (grid < 0) return;
    KArgs a{};
    for (int i = 0; i < 20; ++i) a.in[i] = (const float*)d_in[i];
    a.out = (float*)d_out; a.ws = (unsigned char*)d_ws;
    void* args[] = {&a};
    hipError_t e = hipLaunchCooperativeKernel((const void*)hymba_fwd, dim3(grid), dim3(NTHR), args, LDS_BYTES, stream);
    if (e != hipSuccess) fprintf(stderr, "cooperative launch failed: %s (grid %d)\n", hipGetErrorString(e), grid);
}
```

```cpp
#include <hip/hip_runtime.h>
#include <hip/hip_cooperative_groups.h>
#include <cstdio>
#include <cstdint>
namespace cg = cooperative_groups;
__device__ __forceinline__ int make_tid(int wave0) { int t = wave0 * 64 + (int)__builtin_amdgcn_mbcnt_hi(~0u, __builtin_amdgcn_mbcnt_lo(~0u, 0u)); asm volatile("" : "+v"(t)); return t; }
__device__ __forceinline__ int opaque_bid() { int b = blockIdx.x; asm volatile("" : "+s"(b)); return b; }
namespace pg8 {
#define PG8_LAS __attribute__((address_space(3)))
typedef unsigned short bf16_t;
typedef short bf16x8 __attribute__((ext_vector_type(8)));
typedef float f32x4 __attribute__((ext_vector_type(4)));
typedef unsigned u32x4 __attribute__((ext_vector_type(4)));
constexpr int BM = 256, BK = 64, HALF = 128, HTB = HALF * BK * 2  , STAGE_BYTES = 8 * HTB, NXCD = 8, WGM = 8;

__host__ __device__ __forceinline__ int lds_byte(int r, int c) { const int st = (r >> 4) * 2 + (c >> 5), rr = r & 15, cc = c & 31, ob = rr * 64 + cc * 2; return st * 1024 + (ob ^ (((ob >> 9) & 1) << 5)); }
__host__ __device__ __forceinline__ void stage_rc(int b, int& R, int& C) { const int st = b / 1024, sb = b % 1024, swz = sb ^ (((sb >> 9) & 1) << 5); R = (st >> 1) * 16 + swz / 64; C = (st & 1) * 32 + (swz % 64) / 2; }
__host__ __device__ __forceinline__ int perm32(int rho) { const int n = rho >> 4, i = rho & 15; return 8 * (i >> 2) + 4 * n + (i & 3); }

struct Unit { int pm, pn; };
struct Gemm { const bf16_t* A; const bf16_t* Bt; int M, N, K; };

struct StaticOrder {
    int nM, nN, nwg, G, c;
    __host__ __device__ void init(int M, int N, int G_, int c_) { nM = M / BM; nN = N / BM; nwg = nM * nN; G = G_; c = c_; }
    __host__ __device__ bool next(int i, Unit& u) const {
        const long L = (long)i * G + c; if (L >= nwg) return false;
        int wgid = (int)L; { const int q = nwg / NXCD, r = nwg % NXCD, xcd = wgid % NXCD, off = wgid / NXCD; wgid = (xcd < r ? xcd * (q + 1) : r * (q + 1) + (xcd - r) * q) + off; }
        const int nig = WGM * nN, gid = wgid / nig, fm = gid * WGM, gsz = (nM - fm) < WGM ? (nM - fm) : WGM;
        u.pm = fm + ((wgid % nig) % gsz); u.pn = (wgid % nig) / gsz; return true;
    }
    __device__ __forceinline__ void a_ready(const Unit&) const {}
    __device__ __forceinline__ void done(const Unit&) const {}
};

__device__ __forceinline__ unsigned cvt_pk_bf16(float lo, float hi) { unsigned r; asm volatile("v_cvt_pk_bf16_f32 %0, %1, %2" : "=v"(r) : "v"(lo), "v"(hi)); return r; }
typedef float f32x2 __attribute__((ext_vector_type(2)));
template <class Epi, class Sched, bool ALIGN_EPI = false, bool SP2 = false>
__device__ __forceinline__ void gemm_phase(PG8_LAS unsigned char* lds, const Gemm g, const Sched& S, const Epi& E, const int wave0) {
    const int tid = make_tid(wave0), wid = wave0, lane = tid & 63, wr = wid >> 2, wc = wid & 3, fr = lane & 15, fq = lane >> 4;
    const int K = g.K, nt = K / BK;
    unsigned voffA[2], voffB[2];
#pragma unroll
    for (int i = 0; i < 2; ++i) { int R, C; stage_rc(tid * 16 + i * 8192, R, C); const int Rb = Epi::PERM ? ((R & ~31) + perm32(R & 31)) : R;
        voffA[i] = (unsigned)(R * K + C) * 2u; voffB[i] = (unsigned)(Rb * K + C) * 2u; }
    const size_t kstep = (size_t)(BK * 2);
    const size_t hstep = (size_t)HALF * K * 2;
    const size_t tstep = 2 * hstep;
    const unsigned ldsw = (unsigned)wid * 1024u;
    const int aoff = lds_byte(wr * 64 + fr, fq * 8), boff = lds_byte(wc * 32 + fr, fq * 8);
#define PG8_SA(b, h) (((b) * 2 + (h)) * HTB)
#define PG8_SB(b, h) ((4 + (b) * 2 + (h)) * HTB)
#define PG8_STAGE(bufoff, gbase, voff) do { _Pragma("unroll") for (int _i = 0; _i < 2; ++_i) \
        __builtin_amdgcn_global_load_lds((const unsigned*)((const char*)(gbase) + (voff)[_i]), (PG8_LAS unsigned*)(lds + (bufoff) + ldsw + _i * 8192), 16, 0, 0); } while (0)
#define PG8_LDA(dst, b, h) do { _Pragma("unroll") for (int m = 0; m < 4; ++m) _Pragma("unroll") for (int k = 0; k < 2; ++k) dst[m][k] = *(const PG8_LAS bf16x8*)(lds + PG8_SA(b, h) + aoff + m * 2048 + k * 1024); } while (0)
#define PG8_LDB(dst, b, h) do { _Pragma("unroll") for (int n = 0; n < 2; ++n) _Pragma("unroll") for (int k = 0; k < 2; ++k) dst[n][k] = *(const PG8_LAS bf16x8*)(lds + PG8_SB(b, h) + boff + n * 2048 + k * 1024); } while (0)
#define PG8_MMA(ai, bj, At, Bt) do { __builtin_amdgcn_s_setprio(1); _Pragma("unroll") for (int m = 0; m < 4; ++m) _Pragma("unroll") for (int n = 0; n < 2; ++n) _Pragma("unroll") for (int k = 0; k < 2; ++k) \
        acc[ai][bj][m][n] = __builtin_amdgcn_mfma_f32_16x16x32_bf16(Bt[n][k], At[m][k], acc[ai][bj][m][n], 0, 0, 0); __builtin_amdgcn_s_setprio(0); } while (0)
#define PG8_WAIT_V(n) asm volatile("s_waitcnt vmcnt(" #n ")" ::: "memory")
#define PG8_WAIT_L(n) asm volatile("s_waitcnt lgkmcnt(" #n ")" ::: "memory")
#define PG8_BAR __builtin_amdgcn_s_barrier()
#define PG8_SCHED __builtin_amdgcn_sched_barrier(0)
    Unit cur, nxt; int ui = 0;
    if (!S.next(0, cur)) return;
    f32x4 acc[2][2][4][2];
#pragma unroll
    for (int a = 0; a < 2; ++a)
#pragma unroll
        for (int b = 0; b < 2; ++b)
#pragma unroll
            for (int m = 0; m < 4; ++m)
#pragma unroll
                for (int n = 0; n < 2; ++n) acc[a][b][m][n] = (f32x4){0.f, 0.f, 0.f, 0.f};
    bf16x8 At[4][2], B0[2][2], B1[2][2];
    const char* cA = (const char*)g.A + (size_t)cur.pm * tstep; const char* cB = (const char*)g.Bt + (size_t)cur.pn * tstep;
    S.a_ready(cur);
    if constexpr (SP2) {
        PG8_STAGE(PG8_SB(0, 0), cB, voffB); PG8_STAGE(PG8_SB(0, 1), cB + hstep, voffB); PG8_STAGE(PG8_SA(0, 0), cA, voffA); PG8_STAGE(PG8_SA(0, 1), cA + hstep, voffA);
        if (wr == 1) PG8_BAR;
        PG8_WAIT_V(2); PG8_BAR;
        PG8_STAGE(PG8_SB(1, 0), cB + kstep, voffB); PG8_STAGE(PG8_SA(1, 0), cA + kstep, voffA); PG8_STAGE(PG8_SB(1, 1), cB + hstep + kstep, voffB);
        PG8_WAIT_V(6); PG8_BAR;
    } else {
        PG8_STAGE(PG8_SB(0, 0), cB, voffB); PG8_STAGE(PG8_SA(0, 0), cA, voffA); PG8_STAGE(PG8_SB(0, 1), cB + hstep, voffB); PG8_STAGE(PG8_SA(0, 1), cA + hstep, voffA);
        if (wr == 1) PG8_BAR;
        PG8_WAIT_V(4); PG8_BAR;
        PG8_STAGE(PG8_SB(1, 0), cB + kstep, voffB); PG8_STAGE(PG8_SA(1, 0), cA + kstep, voffA); PG8_STAGE(PG8_SB(1, 1), cB + hstep + kstep, voffB);
        PG8_WAIT_V(6); PG8_BAR;
    }
    for (;;) {
        const bool has_next = S.next(ui + 1, nxt);
        const char* nA = has_next ? (const char*)g.A + (size_t)nxt.pm * tstep : cA; const char* nB = has_next ? (const char*)g.Bt + (size_t)nxt.pn * tstep : cB;
        for (int t = 0; t < nt; t += 2) {
            const bool last = (t == nt - 2);
            const char* a1 = cA + (size_t)(t + 1) * kstep;
            const char* a2 = last ? nA : cA + (size_t)(t + 2) * kstep; const char* b2 = last ? nB : cB + (size_t)(t + 2) * kstep;
            const char* a3 = a2 + kstep; const char* b3 = b2 + kstep;
            if (last && has_next) S.a_ready(nxt);
            if constexpr (SP2) {
            PG8_LDB(B0, 0, 0); PG8_LDB(B1, 0, 1); PG8_SCHED; PG8_LDA(At, 0, 0); PG8_STAGE(PG8_SA(1, 1), a1 + hstep, voffA);
            PG8_WAIT_V(8); PG8_WAIT_L(0); PG8_BAR; PG8_MMA(0, 0, At, B0); PG8_MMA(0, 1, At, B1); PG8_BAR; PG8_SCHED;
            PG8_LDA(At, 0, 1); PG8_STAGE(PG8_SB(0, 0), b2, voffB); PG8_STAGE(PG8_SB(0, 1), b2 + hstep, voffB); PG8_STAGE(PG8_SA(0, 0), a2, voffA);
            PG8_WAIT_V(8); PG8_WAIT_L(0); PG8_BAR; PG8_MMA(1, 0, At, B0); PG8_MMA(1, 1, At, B1); PG8_BAR; PG8_SCHED;
            PG8_LDB(B0, 1, 0); PG8_LDB(B1, 1, 1); PG8_SCHED; PG8_LDA(At, 1, 0); PG8_STAGE(PG8_SA(0, 1), a2 + hstep, voffA);
            PG8_WAIT_V(8); PG8_WAIT_L(0); PG8_BAR; PG8_MMA(0, 0, At, B0); PG8_MMA(0, 1, At, B1); PG8_BAR; PG8_SCHED;
            PG8_LDA(At, 1, 1); PG8_STAGE(PG8_SB(1, 0), b3, voffB); PG8_STAGE(PG8_SB(1, 1), b3 + hstep, voffB); PG8_STAGE(PG8_SA(1, 0), a3, voffA);
            PG8_WAIT_V(8); PG8_WAIT_L(0); PG8_BAR; PG8_MMA(1, 0, At, B0); PG8_MMA(1, 1, At, B1); PG8_BAR; PG8_SCHED;
            } else {
            PG8_LDB(B0, 0, 0); PG8_SCHED; PG8_LDA(At, 0, 0); PG8_STAGE(PG8_SA(1, 1), a1 + hstep, voffA);
            PG8_WAIT_L(8); PG8_BAR; PG8_WAIT_L(0); PG8_MMA(0, 0, At, B0); PG8_BAR; PG8_SCHED;
            PG8_LDB(B1, 0, 1); PG8_STAGE(PG8_SB(0, 0), b2, voffB);
            PG8_BAR; PG8_WAIT_L(0); PG8_MMA(0, 1, At, B1); PG8_BAR;
            PG8_LDA(At, 0, 1); PG8_STAGE(PG8_SA(0, 0), a2, voffA);
            PG8_BAR; PG8_WAIT_L(0); PG8_MMA(1, 0, At, B0); PG8_BAR; PG8_SCHED;
            PG8_STAGE(PG8_SB(0, 1), b2 + hstep, voffB);
            PG8_WAIT_V(6); PG8_BAR; PG8_MMA(1, 1, At, B1); PG8_BAR;
            PG8_LDB(B0, 1, 0); PG8_SCHED; PG8_LDA(At, 1, 0); PG8_STAGE(PG8_SA(0, 1), a2 + hstep, voffA);
            PG8_WAIT_L(8); PG8_BAR; PG8_WAIT_L(0); PG8_MMA(0, 0, At, B0); PG8_BAR; PG8_SCHED;
            PG8_LDB(B1, 1, 1); PG8_STAGE(PG8_SB(1, 0), b3, voffB);
            PG8_BAR; PG8_WAIT_L(0); PG8_MMA(0, 1, At, B1); PG8_BAR;
            PG8_LDA(At, 1, 1); PG8_STAGE(PG8_SA(1, 0), a3, voffA);
            PG8_BAR; PG8_WAIT_L(0); PG8_MMA(1, 0, At, B0); PG8_BAR; PG8_SCHED;
            PG8_STAGE(PG8_SB(1, 1), b3 + hstep, voffB);
            PG8_WAIT_V(6); PG8_BAR; PG8_MMA(1, 1, At, B1); PG8_BAR;
            }
        }
        if constexpr (ALIGN_EPI) { if (wr == 0) PG8_BAR; }
        if constexpr (!Epi::AFTER_DRAIN) { E(acc, cur, wr, wc, fr, fq); S.done(cur); }
        if (!has_next) break;
#pragma unroll
        for (int a = 0; a < 2; ++a)
#pragma unroll
            for (int b = 0; b < 2; ++b)
#pragma unroll
                for (int m = 0; m < 4; ++m)
#pragma unroll
                    for (int n = 0; n < 2; ++n) acc[a][b][m][n] = (f32x4){0.f, 0.f, 0.f, 0.f};
        cur = nxt; cA = nA; cB = nB; ++ui;
        if constexpr (ALIGN_EPI) { if (wr == 1) PG8_BAR; }
    }
    PG8_WAIT_V(0);
    if constexpr (!ALIGN_EPI) { if (wr == 0) PG8_BAR; }
    PG8_BAR;
    if constexpr (Epi::AFTER_DRAIN) { E.fused(acc, cur, wr, wc, fr, fq, lds, wid, lane); S.done(cur); }
#undef PG8_SA
#undef PG8_SB
#undef PG8_STAGE
#undef PG8_LDA
#undef PG8_LDB
#undef PG8_MMA
#undef PG8_WAIT_V
#undef PG8_WAIT_L
#undef PG8_BAR
#undef PG8_SCHED
}
}

#define LAS __attribute__((address_space(3)))
#define GAS __attribute__((address_space(1)))
typedef unsigned short bf16_t;
typedef short bf16x8 __attribute__((ext_vector_type(8)));
typedef float f32x4 __attribute__((ext_vector_type(4)));
typedef float f32x2 __attribute__((ext_vector_type(2)));
typedef float f32x16 __attribute__((ext_vector_type(16)));
typedef unsigned u32x4 __attribute__((ext_vector_type(4)));
typedef unsigned u32x2 __attribute__((ext_vector_type(2)));
typedef short v4i16_t __attribute__((ext_vector_type(4)));
typedef __bf16 bf16x2_t __attribute__((ext_vector_type(2)));

constexpr int BATCH = 8, SEQ = 4096, DM = 1024, FF = 2816, NPJ = 2560, NIN = 2488;
constexpr int MROWS = BATCH * SEQ;
constexpr float EPS = 1e-6f;
constexpr float LOG2E = 1.4426950408889634f;
constexpr int C_CQ = 0, C_CKV = 256, C_KR = 384, C_DQ = 416, C_DK = 672, C_DV = 928, C_NQ = 1184, C_NKV = 1696, C_NG = 2464;
constexpr float QS_MLA = 0.14724444602590306f;
constexpr float QS_DIFF = 0.25503486164919736f;
constexpr float QS_NSA = 0.18033688011112042f;

constexpr size_t al256(size_t x) { return (x + 255) & ~(size_t)255; }
constexpr size_t WS_CTL = 0;
constexpr size_t WS_PTAB = 3072;
constexpr size_t WS_TAB32 = 4096;
constexpr size_t WS_TAB64 = WS_TAB32 + (size_t)SEQ * 16 * 8;
constexpr size_t WS_WGU = WS_TAB64 + (size_t)SEQ * 32 * 8;
constexpr size_t SZ_WGU = (size_t)2 * FF * DM * 2;
constexpr size_t WS_WD = WS_WGU + 4 * SZ_WGU;
constexpr size_t SZ_WD = (size_t)DM * FF * 2;
constexpr size_t WS_WIN = WS_WD + 4 * SZ_WD;
constexpr size_t SZ_WIN = (size_t)NPJ * DM * 2;
constexpr size_t WS_WOUT = WS_WIN + 2 * SZ_WIN;
constexpr size_t SZ_WOUT = (size_t)DM * DM * 2;
constexpr size_t WS_WUQ = WS_WOUT + 2 * SZ_WOUT;
constexpr size_t SZ_WUQ = (size_t)512 * 256 * 2;
constexpr size_t WS_WUKV = WS_WUQ + 2 * SZ_WUQ;
constexpr size_t SZ_WUKV = (size_t)512 * 128 * 2;
constexpr size_t WS_W1 = WS_WUKV + 2 * SZ_WUKV;
constexpr size_t SZ_W1 = (size_t)256 * 2048 * 2;
constexpr size_t WS_W2 = WS_W1 + 4 * SZ_W1;
constexpr size_t SZ_W2 = (size_t)256 * 256 * 2;
constexpr size_t WS_HN = WS_W2 + 4 * SZ_W2;
constexpr size_t WS_ACT = WS_HN + (size_t)MROWS * DM * 2;
constexpr size_t WS_QM = WS_ACT + (size_t)MROWS * FF * 2;
constexpr size_t WS_KMLA = WS_QM + (size_t)MROWS * 384 * 2;
constexpr size_t WS_HN2 = WS_QM;
constexpr size_t WS_VMLA = WS_KMLA + (size_t)MROWS * 384 * 2;
constexpr size_t WS_CQN = WS_VMLA + (size_t)MROWS * 256 * 2;
constexpr size_t WS_CKVN = WS_CQN + (size_t)MROWS * 256 * 2;
constexpr size_t WS_FLATK = WS_CKVN + (size_t)MROWS * 128 * 2;
constexpr size_t WS_FLATV = WS_FLATK + (size_t)4096 * 2048 * 2;
constexpr size_t WS_HIDK = WS_FLATV + (size_t)4096 * 2048 * 2;
constexpr size_t WS_HIDV = WS_HIDK + (size_t)4096 * 256 * 2;
constexpr size_t WS_KC = WS_HIDV + (size_t)4096 * 256 * 2;
constexpr size_t WS_VC = WS_KC + (size_t)4096 * 64 * 2;
constexpr size_t WS_GATES = WS_VC + (size_t)4096 * 64 * 2;
constexpr size_t WS_MASK = WS_GATES + (size_t)MROWS * 24 * 4;
constexpr size_t WS_OCMP = WS_MASK + (size_t)16 * SEQ * 8;
constexpr size_t WS_BAR = WS_OCMP + (size_t)MROWS * 512 * 2;
constexpr size_t WS_SS = WS_BAR + 16384;
constexpr size_t WS_END = WS_SS + (size_t)6 * MROWS * 4;

constexpr int LDS_BYTES = 147456;
constexpr int MISC_OFF = 147456 - 512;
constexpr int SC_OFF = 69632;
constexpr int MI_OFF = SC_OFF + 8 * 32 * 65 * 4;
static_assert(MI_OFF + 8 * 1024 <= MISC_OFF, "cmp LDS map");
static_assert(WS_CQN - WS_QM == (size_t)MROWS * DM * 2, "HN2 overlay");
constexpr int NTHR = 512;

__device__ __forceinline__ float bf2f(bf16_t h) { return __uint_as_float((unsigned)h << 16); }
__device__ __forceinline__ unsigned cvtpk(float lo, float hi) { f32x2 v = {lo, hi}; bf16x2_t b = __builtin_convertvector(v, bf16x2_t); return __builtin_bit_cast(unsigned, b); }
__device__ __forceinline__ bf16_t f2bf(float f) { return (bf16_t)(cvtpk(f, 0.f) & 0xffffu); }
#define SWZ_XOR(v, m) __uint_as_float((unsigned)__builtin_amdgcn_ds_swizzle((int)__float_as_uint(v), ((m) << 10) | 0x1f))
__device__ __forceinline__ float sum32x(float v) { auto rr = __builtin_amdgcn_permlane32_swap(__float_as_uint(v), __float_as_uint(v), false, false); return __uint_as_float(rr[0]) + __uint_as_float(rr[1]); }
__device__ __forceinline__ float max32x(float v) { auto rr = __builtin_amdgcn_permlane32_swap(__float_as_uint(v), __float_as_uint(v), false, false); return fmaxf(__uint_as_float(rr[0]), __uint_as_float(rr[1])); }
__device__ __forceinline__ unsigned or32x(unsigned v) { auto rr = __builtin_amdgcn_permlane32_swap(v, v, false, false); return rr[0] | rr[1]; }
__device__ __forceinline__ float partner32(float v, int hi) { auto rr = __builtin_amdgcn_permlane32_swap(__float_as_uint(v), __float_as_uint(v), false, false); return __uint_as_float(hi ? rr[0] : rr[1]); }
__device__ __forceinline__ float wave_sum(float v) {
    v += SWZ_XOR(v, 1); v += SWZ_XOR(v, 2); v += SWZ_XOR(v, 4); v += SWZ_XOR(v, 8); v += SWZ_XOR(v, 16);
    return sum32x(v);
}
__device__ __forceinline__ float silu_f(float x) { return x * __builtin_amdgcn_rcpf(1.0f + __builtin_amdgcn_exp2f(-LOG2E * x)); }
__device__ __forceinline__ int crow(int r, int hi) { return (r & 3) + 8 * (r >> 2) + 4 * hi; }
#define LDS_WAIT() asm volatile("s_waitcnt lgkmcnt(0)" ::: "memory")
__device__ __forceinline__ float max3f(float a, float b, float c) { float r; asm("v_max3_f32 %0, %1, %2, %3" : "=v"(r) : "v"(a), "v"(b), "v"(c)); return r; }
__device__ __forceinline__ float fadd_s(float a, float b) { float r; asm("v_add_f32_e32 %0, %1, %2" : "=v"(r) : "v"(a), "v"(b)); return r; }

enum { EK_ACT = 0, EK_RES = 1, EK_BF16 = 2, EK_QUP = 3, EK_KVUP = 4 };
struct EpiP { int kind, ldc, ncols, flags; float coef; int pad; const GAS float* fin; GAS float* fout; GAS bf16_t* o0; GAS bf16_t* o1; const GAS float* aux; };
template <bool PERM_> struct EpiGenT {
    static constexpr bool PERM = PERM_, AFTER_DRAIN = false;
    const EpiP* p;
    __device__ __forceinline__ void operator()(const pg8::f32x4 (&acc)[2][2][4][2], const pg8::Unit& u, int wr, int wc, int fr, int fq) const {
        const int kind = p->kind, ldc = p->ldc, ncols = p->ncols, flags = p->flags; const float coef = p->coef;
        const float* fin = (const float*)p->fin; float* fout = (float*)p->fout; bf16_t* o0 = (bf16_t*)p->o0; bf16_t* o1 = (bf16_t*)p->o1; const float* aux = (const float*)p->aux;
        const int rowb = u.pm * 256 + wr * 64 + fr;
        const int colb = u.pn * 256 + wc * 32 + (PERM ? 8 : 4) * fq;
        constexpr int NS = PERM ? 4 : 16;
        if (kind == EK_ACT) {
            float rsv[2][4];
#pragma unroll
            for (int ai = 0; ai < 2; ++ai)
#pragma unroll
                for (int m = 0; m < 4; ++m) rsv[ai][m] = fin[rowb + 128 * ai + 16 * m];
#pragma unroll
            for (int ai = 0; ai < 2; ++ai)
#pragma unroll
                for (int m = 0; m < 4; ++m) {
                    bf16_t* rp = o0 + (size_t)(rowb + 128 * ai + 16 * m) * ldc + u.pn * 128 + wc * 32 + (PERM ? 8 : 4) * fq;
                    const float rs = __builtin_amdgcn_rsqf(rsv[ai][m] * (1.0f / DM) + EPS);
                    u32x2 wn[2];
#pragma unroll
                    for (int n = 0; n < 2; ++n) {
                        const pg8::f32x4 g = acc[ai][0][m][n] * rs, up = acc[ai][1][m][n] * rs;
                        wn[n].x = cvtpk(silu_f(g[0]) * up[0], silu_f(g[1]) * up[1]); wn[n].y = cvtpk(silu_f(g[2]) * up[2], silu_f(g[3]) * up[3]);
                    }
                    if (PERM) { *(u32x4*)rp = (u32x4){wn[0].x, wn[0].y, wn[1].x, wn[1].y}; }
                    else { *(u32x2*)rp = wn[0]; *(u32x2*)(rp + 16) = wn[1]; }
                }
        } else if (kind == EK_RES) {
#pragma unroll
            for (int ai = 0; ai < 2; ++ai) {
                pg8::f32x4 pre[4][2][2];
#pragma unroll
                for (int m = 0; m < 4; ++m) {
                    const size_t ro = (size_t)(rowb + 128 * ai + 16 * m) * ldc + colb;
#pragma unroll
                    for (int bj = 0; bj < 2; ++bj)
#pragma unroll
                        for (int n = 0; n < 2; ++n) pre[m][bj][n] = *(const pg8::f32x4*)(fin + ro + 128 * bj + NS * n);
                }
#pragma unroll
                for (int m = 0; m < 4; ++m) {
                    const size_t ro = (size_t)(rowb + 128 * ai + 16 * m) * ldc + colb;
                    float ssr = 0.f;
#pragma unroll
                    for (int bj = 0; bj < 2; ++bj)
#pragma unroll
                        for (int n = 0; n < 2; ++n) {
                            const size_t off = ro + 128 * bj + NS * n;
                            const pg8::f32x4 v = pre[m][bj][n] + acc[ai][bj][m][n] * coef;
                            *(pg8::f32x4*)(fout + off) = v;
                            if (flags & 2) { u32x2 w; w.x = cvtpk(v[0], v[1]); w.y = cvtpk(v[2], v[3]); *(u32x2*)(o0 + off) = w; ssr += (v[0] * v[0] + v[1] * v[1]) + (v[2] * v[2] + v[3] * v[3]); }
                        }
                    if (flags & 2) { ssr += SWZ_XOR(ssr, 16); ssr = sum32x(ssr); if (fq == 0) atomicAdd((float*)o1 + (rowb + 128 * ai + 16 * m), ssr); }
                }
            }
        } else if (kind == EK_BF16 && PERM) {
#pragma unroll
            for (int bj = 0; bj < 2; ++bj) {
                const int c = colb + 128 * bj;
                if (c < ncols) {
#pragma unroll
                    for (int ai = 0; ai < 2; ++ai)
#pragma unroll
                        for (int m = 0; m < 4; ++m) {
                            pg8::f32x4 v0 = acc[ai][bj][m][0], v1 = acc[ai][bj][m][1];
                            if (flags & 4) { const float rs = __builtin_amdgcn_rsqf(fin[rowb + 128 * ai + 16 * m] * (1.0f / DM) + EPS); v0 = v0 * rs; v1 = v1 * rs; }
                            *(u32x4*)(o0 + (size_t)(rowb + 128 * ai + 16 * m) * ldc + c) = (u32x4){cvtpk(v0[0], v0[1]), cvtpk(v0[2], v0[3]), cvtpk(v1[0], v1[1]), cvtpk(v1[2], v1[3])};
                        }
                }
            }
        } else if (kind == EK_BF16) {
#pragma unroll
            for (int bj = 0; bj < 2; ++bj)
#pragma unroll
                for (int n = 0; n < 2; ++n) {
                    const int c = colb + 128 * bj + NS * n;
                    if (c < ncols) {
                        pg8::f32x4 bv = (pg8::f32x4){0.f, 0.f, 0.f, 0.f};
                        if (aux) bv = *(const pg8::f32x4*)(aux + c);
#pragma unroll
                        for (int ai = 0; ai < 2; ++ai)
#pragma unroll
                            for (int m = 0; m < 4; ++m) {
                                pg8::f32x4 v = acc[ai][bj][m][n] + bv;
                                if (flags & 4) v = v * __builtin_amdgcn_rsqf(fin[rowb + 128 * ai + 16 * m] * (1.0f / DM) + EPS);
                                if (flags & 1) { v[0] = silu_f(v[0]); v[1] = silu_f(v[1]); v[2] = silu_f(v[2]); v[3] = silu_f(v[3]); }
                                u32x2 w; w.x = cvtpk(v[0], v[1]); w.y = cvtpk(v[2], v[3]);
                                *(u32x2*)(o0 + (size_t)(rowb + 128 * ai + 16 * m) * ldc + c) = w;
                            }
                    }
                }
        } else if (PERM) {
        } else if (kind == EK_QUP) {
#pragma unroll
            for (int bj = 0; bj < 2; ++bj) {
                const int cg32 = u.pn * 256 + 128 * bj + wc * 32;
                if (cg32 < 384) {
                    const bool rope = ((cg32 >> 5) % 3) == 2;
#pragma unroll
                    for (int ai = 0; ai < 2; ++ai)
#pragma unroll
                        for (int m = 0; m < 4; ++m) {
                            const int row = rowb + 128 * ai + 16 * m;
                            pg8::f32x4 x1 = acc[ai][bj][m][0], x2 = acc[ai][bj][m][1];
                            if (rope) {
                                const float* tp = aux + ((size_t)(row & (SEQ - 1)) * 16 + 4 * fq) * 2;
                                const pg8::f32x4 cs0 = *(const pg8::f32x4*)tp, cs1 = *(const pg8::f32x4*)(tp + 4);
                                const pg8::f32x4 cc = {cs0[0], cs0[2], cs1[0], cs1[2]}, ss = {cs0[1], cs0[3], cs1[1], cs1[3]};
                                const pg8::f32x4 y1 = x1 * cc - x2 * ss, y2 = x2 * cc + x1 * ss;
                                x1 = y1; x2 = y2;
                            }
                            x1 = x1 * QS_MLA; x2 = x2 * QS_MLA;
                            bf16_t* rp = o0 + (size_t)row * 384 + cg32 + 4 * fq;
                            u32x2 w; w.x = cvtpk(x1[0], x1[1]); w.y = cvtpk(x1[2], x1[3]); *(u32x2*)rp = w;
                            w.x = cvtpk(x2[0], x2[1]); w.y = cvtpk(x2[2], x2[3]); *(u32x2*)(rp + 16) = w;
                        }
                }
            }
        } else {
#pragma unroll
            for (int bj = 0; bj < 2; ++bj)
#pragma unroll
                for (int n = 0; n < 2; ++n) {
                    const int c = colb + 128 * bj + NS * n;
                    const int head = c >> 7, isv = (c >> 6) & 1, d = c & 63;
#pragma unroll
                    for (int ai = 0; ai < 2; ++ai)
#pragma unroll
                        for (int m = 0; m < 4; ++m) {
                            const int row = rowb + 128 * ai + 16 * m;
                            const pg8::f32x4 v = acc[ai][bj][m][n];
                            u32x2 w; w.x = cvtpk(v[0], v[1]); w.y = cvtpk(v[2], v[3]);
                            bf16_t* p = isv ? (o1 + (size_t)row * 256 + head * 64 + d) : (o0 + (size_t)row * 384 + head * 96 + d);
                            *(u32x2*)p = w;
                        }
                }
        }
    }
};

struct GemmDesc { const bf16_t* A; const bf16_t* Bt; int M, N, K, rot; EpiP e; };

__device__ __forceinline__ void transpose_mat(const float* __restrict__ W, int K, int N, int Npad, bf16_t* __restrict__ WT, int blk_mul, int blk_off,
                                              LAS float* scr, int gw, int NGW, int lane, const float* __restrict__ gk = nullptr) {
    const int nblk = Npad / 32, nitems = (K / 64) * nblk;
    for (int it = gw; it < nitems; it += NGW) {
        const int kb = it / nblk, nb = it % nblk, k0 = 64 * kb, n0 = 32 * nb;
        const int ncol = n0 + (lane & 31);
#pragma unroll
        for (int i = 0; i < 32; ++i) { const int kk = 2 * i + (lane >> 5); float w = (ncol < N) ? W[(size_t)(k0 + kk) * N + ncol] : 0.f; if (gk) w *= gk[k0 + kk]; scr[kk * 33 + (lane & 31)] = w; }
        LDS_WAIT();
        const int c = lane & 7;
#pragma unroll
        for (int j = 0; j < 4; ++j) {
            const int n = (lane >> 3) + 8 * j; const LAS float* s = scr + (8 * c) * 33 + n;
            u32x4 o; o.x = cvtpk(s[0 * 33], s[1 * 33]); o.y = cvtpk(s[2 * 33], s[3 * 33]); o.z = cvtpk(s[4 * 33], s[5 * 33]); o.w = cvtpk(s[6 * 33], s[7 * 33]);
            const int nn = n0 + n, orow = (nn / 128) * blk_mul + blk_off + (nn % 128);
            *(u32x4*)(WT + (size_t)orow * K + k0 + 8 * c) = o;
        }
        LDS_WAIT();
    }
}

__device__ __forceinline__ void sincos_acc(float ang, float& c, float& s) {
    const double a = (double)ang;
    const double kq = __builtin_rint(a * 0.6366197723675814);
    double r = __builtin_fma(-kq, 1.5707963267948966, a);
    r = __builtin_fma(-kq, 6.123233995736766e-17, r);
    const double r2 = r * r;
    const double sp = r * (1.0 + r2 * (-1.0 / 6 + r2 * (1.0 / 120 + r2 * (-1.0 / 5040 + r2 * (1.0 / 362880 + r2 * (-1.0 / 39916800))))));
    const double cp = 1.0 + r2 * (-0.5 + r2 * (1.0 / 24 + r2 * (-1.0 / 720 + r2 * (1.0 / 40320 + r2 * (-1.0 / 3628800 + r2 * (1.0 / 479001600))))));
    const int q = ((int)kq) & 3;
    const double sv = (q == 0) ? sp : (q == 1) ? cp : (q == 2) ? -sp : -cp;
    const double cv = (q == 0) ? cp : (q == 1) ? -sp : (q == 2) ? -cp : sp;
    c = (float)cv; s = (float)sv;
}

__device__ __forceinline__ void norm_rows_bf16(const float* __restrict__ x, const float* __restrict__ g, bf16_t* __restrict__ out, int gw, int NGW, int lane) {
    for (int m = gw; m < MROWS; m += NGW) {
        const f32x4* xr = (const f32x4*)(x + (size_t)m * DM) + lane;
        f32x4 v[4]; float ss = 0.f;
#pragma unroll
        for (int j = 0; j < 4; ++j) { v[j] = xr[64 * j]; ss += (v[j][0] * v[j][0] + v[j][1] * v[j][1]) + (v[j][2] * v[j][2] + v[j][3] * v[j][3]); }
        const float rstd = 1.0f / sqrtf(wave_sum(ss) * (1.0f / DM) + EPS);
        u32x2* o8 = (u32x2*)(out + (size_t)m * DM) + lane;
#pragma unroll
        for (int j = 0; j < 4; ++j) { const f32x4 gv = ((const f32x4*)g)[lane + 64 * j];
            u32x2 w; w.x = cvtpk(v[j][0] * rstd * gv[0], v[j][1] * rstd * gv[1]); w.y = cvtpk(v[j][2] * rstd * gv[2], v[j][3] * rstd * gv[3]); o8[64 * j] = w; }
    }
}
__device__ __forceinline__ void norm_rows_f32_inplace(float* __restrict__ x, const float* __restrict__ g, int gw, int NGW, int lane) {
    for (int m = gw; m < MROWS; m += 2 * NGW) {
        const int m2 = m + NGW;
        f32x4* xa = (f32x4*)(x + (size_t)m * DM) + lane;
        f32x4* xb = (f32x4*)(x + (size_t)(m2 < MROWS ? m2 : m) * DM) + lane;
        f32x4 va[4], vb[4]; float sa = 0.f, sb = 0.f;
#pragma unroll
        for (int j = 0; j < 4; ++j) { va[j] = xa[64 * j]; vb[j] = xb[64 * j]; }
#pragma unroll
        for (int j = 0; j < 4; ++j) { sa += (va[j][0] * va[j][0] + va[j][1] * va[j][1]) + (va[j][2] * va[j][2] + va[j][3] * va[j][3]);
                                      sb += (vb[j][0] * vb[j][0] + vb[j][1] * vb[j][1]) + (vb[j][2] * vb[j][2] + vb[j][3] * vb[j][3]); }
        const float ra = 1.0f / sqrtf(wave_sum(sa) * (1.0f / DM) + EPS), rb = 1.0f / sqrtf(wave_sum(sb) * (1.0f / DM) + EPS);
#pragma unroll
        for (int j = 0; j < 4; ++j) { const f32x4 gv = ((const f32x4*)g)[lane + 64 * j]; xa[64 * j] = va[j] * ra * gv; if (m2 < MROWS) xb[64 * j] = vb[j] * rb * gv; }
    }
}

struct PostRegs {
    u32x2 r_cq; unsigned r_ckv; unsigned r_kr1, r_kr2; unsigned dq1, dq2, dk1, dk2, nq1[2], nq2[2], nk1[2], nk2[2];
    unsigned r_v; bf16_t r_gate; f32x4 cs32, cs64; f32x2 pk0a, pk0b, pk1a, pk1b, pv0, pv1;
};
__device__ __forceinline__ float bflo(unsigned u) { return __uint_as_float(u << 16); }
__device__ __forceinline__ float bfhi(unsigned u) { return __uint_as_float(u & 0xffff0000u); }
__device__ __forceinline__ void post_load(PostRegs& R, int m, int lane, const bf16_t* __restrict__ P, const float* __restrict__ tab32, const float* __restrict__ tab64,
                                          const float* __restrict__ posK, const float* __restrict__ posV) {
    const bf16_t* pr = P + (size_t)m * NPJ;
    const int t = m & (SEQ - 1);
    const int i16 = 2 * (lane & 7), i32 = 2 * (lane & 15);
    R.r_cq = *(const u32x2*)(pr + C_CQ + 4 * lane);
    R.r_ckv = *(const unsigned*)(pr + C_CKV + 2 * lane);
    R.r_kr1 = *(const unsigned*)(pr + C_KR + i16); R.r_kr2 = *(const unsigned*)(pr + C_KR + 16 + i16);
    { const int ch = lane >> 3;
      R.dq1 = *(const unsigned*)(pr + C_DQ + ch * 32 + i16); R.dq2 = *(const unsigned*)(pr + C_DQ + ch * 32 + 16 + i16);
      R.dk1 = *(const unsigned*)(pr + C_DK + ch * 32 + i16); R.dk2 = *(const unsigned*)(pr + C_DK + ch * 32 + 16 + i16); }
#pragma unroll
    for (int rep = 0; rep < 2; ++rep) { const int ch = (lane + 64 * rep) >> 4; R.nq1[rep] = *(const unsigned*)(pr + C_NQ + ch * 64 + i32); R.nq2[rep] = *(const unsigned*)(pr + C_NQ + ch * 64 + 32 + i32); }
#pragma unroll
    for (int rep = 0; rep < 2; ++rep) { int ch = (lane + 64 * rep) >> 4; ch = ch < 6 ? ch : 5; const int br = ch >> 1, g = ch & 1;
        R.nk1[rep] = *(const unsigned*)(pr + C_NKV + br * 256 + g * 64 + i32); R.nk2[rep] = *(const unsigned*)(pr + C_NKV + br * 256 + g * 64 + 32 + i32); }
    const int vg = (2 * lane) >> 6, vd = (2 * lane) & 63;
    R.r_v = *(const unsigned*)(pr + C_NKV + 128 + vg * 64 + vd);
    R.r_gate = pr[C_NG + (lane < 24 ? lane : 23)];
    R.cs32 = *(const f32x4*)(tab32 + (size_t)t * 32 + 2 * i16);
    R.cs64 = *(const f32x4*)(tab64 + (size_t)t * 64 + 2 * i32);
    const int l0 = t & 15, l1 = l0 + 16;
    R.pk0a = *(const f32x2*)(posK + l0 * 64 + i32); R.pk0b = *(const f32x2*)(posK + l0 * 64 + 32 + i32);
    R.pk1a = *(const f32x2*)(posK + l1 * 64 + i32); R.pk1b = *(const f32x2*)(posK + l1 * 64 + 32 + i32);
    R.pv0 = *(const f32x2*)(posV + l0 * 64 + vd); R.pv1 = *(const f32x2*)(posV + l1 * 64 + vd);
}
#define ROPE2(a, b2, cs, y1a, y1b, y2a, y2b) \
    const float y1a = bflo(a) * cs[0] - bflo(b2) * cs[1], y2a = bflo(b2) * cs[0] + bflo(a) * cs[1]; \
    const float y1b = bfhi(a) * cs[2] - bfhi(b2) * cs[3], y2b = bfhi(b2) * cs[2] + bfhi(a) * cs[3];
__device__ __forceinline__ void post_store(const PostRegs& R, int m, int lane, bf16_t* __restrict__ P, const f32x4 g4, const f32x2 g2, const float gb,
        bf16_t* __restrict__ cqn, bf16_t* __restrict__ ckvn, bf16_t* __restrict__ Kmla, bf16_t* __restrict__ flatK, bf16_t* __restrict__ flatV, float* __restrict__ gates) {
    bf16_t* pr = P + (size_t)m * NPJ;
    const int t = m & (SEQ - 1), b = m >> 12;
    const int i16 = 2 * (lane & 7), i32 = 2 * (lane & 15);
    const int l0 = t & 15, nc0 = t >> 4, l1 = l0 + 16;
    const int vg = (2 * lane) >> 6, vd = (2 * lane) & 63;
    {
        const float v0 = bflo(R.r_cq.x), v1 = bfhi(R.r_cq.x), v2 = bflo(R.r_cq.y), v3 = bfhi(R.r_cq.y);
        const float ss = wave_sum((v0 * v0 + v1 * v1) + (v2 * v2 + v3 * v3));
        const float rstd = 1.0f / sqrtf(ss * (1.0f / 256) + EPS);
        u32x2 w; w.x = cvtpk(v0 * rstd * g4[0], v1 * rstd * g4[1]); w.y = cvtpk(v2 * rstd * g4[2], v3 * rstd * g4[3]);
        *(u32x2*)(cqn + (size_t)m * 256 + 4 * lane) = w;
    }
    {
        const float v0 = bflo(R.r_ckv), v1 = bfhi(R.r_ckv);
        const float ss = wave_sum(v0 * v0 + v1 * v1);
        const float rstd = 1.0f / sqrtf(ss * (1.0f / 128) + EPS);
        *(unsigned*)(ckvn + (size_t)m * 128 + 2 * lane) = cvtpk(v0 * rstd * g2[0], v1 * rstd * g2[1]);
    }
    if (lane < 8) {
        ROPE2(R.r_kr1, R.r_kr2, R.cs32, y1a, y1b, y2a, y2b)
        const unsigned w1 = cvtpk(y1a, y1b), w2 = cvtpk(y2a, y2b);
#pragma unroll
        for (int h = 0; h < 4; ++h) { *(unsigned*)(Kmla + (size_t)m * 384 + h * 96 + 64 + i16) = w1; *(unsigned*)(Kmla + (size_t)m * 384 + h * 96 + 80 + i16) = w2; }
    }
    {
        const int ch = lane >> 3;
        { ROPE2(R.dq1, R.dq2, R.cs32, y1a, y1b, y2a, y2b)
          bf16_t* q = pr + C_DQ + ch * 32 + i16; *(unsigned*)q = cvtpk(y1a * QS_DIFF, y1b * QS_DIFF); *(unsigned*)(q + 16) = cvtpk(y2a * QS_DIFF, y2b * QS_DIFF); }
        { ROPE2(R.dk1, R.dk2, R.cs32, y1a, y1b, y2a, y2b)
          bf16_t* k = pr + C_DK + ch * 32 + i16; *(unsigned*)k = cvtpk(y1a, y1b); *(unsigned*)(k + 16) = cvtpk(y2a, y2b); }
    }
#pragma unroll
    for (int rep = 0; rep < 2; ++rep) {
        const int ch = (lane + 64 * rep) >> 4;
        ROPE2(R.nq1[rep], R.nq2[rep], R.cs64, y1a, y1b, y2a, y2b)
        bf16_t* q = pr + C_NQ + ch * 64 + i32; *(unsigned*)q = cvtpk(y1a * QS_NSA, y1b * QS_NSA); *(unsigned*)(q + 32) = cvtpk(y2a * QS_NSA, y2b * QS_NSA);
    }
#pragma unroll
    for (int rep = 0; rep < 2; ++rep) {
        const int ch = (lane + 64 * rep) >> 4;
        if (ch < 6) {
            const int br = ch >> 1, g = ch & 1;
            ROPE2(R.nk1[rep], R.nk2[rep], R.cs64, y1a, y1b, y2a, y2b)
            bf16_t* k = pr + C_NKV + br * 256 + g * 64 + i32; *(unsigned*)k = cvtpk(y1a, y1b); *(unsigned*)(k + 32) = cvtpk(y2a, y2b);
            if (br == 0) {
                const size_t rowb = (size_t)(b * 2 + g) * 256;
                if (nc0 <= 254) { bf16_t* f = flatK + (rowb + nc0) * 2048 + l0 * 64 + i32; *(unsigned*)f = cvtpk(y1a + R.pk0a[0], y1b + R.pk0a[1]); *(unsigned*)(f + 32) = cvtpk(y2a + R.pk0b[0], y2b + R.pk0b[1]); }
                if (nc0 >= 1) { bf16_t* f = flatK + (rowb + nc0 - 1) * 2048 + l1 * 64 + i32; *(unsigned*)f = cvtpk(y1a + R.pk1a[0], y1b + R.pk1a[1]); *(unsigned*)(f + 32) = cvtpk(y2a + R.pk1b[0], y2b + R.pk1b[1]); }
            }
        }
    }
    {
        const float v0 = bflo(R.r_v), v1 = bfhi(R.r_v);
        const size_t rowb = (size_t)(b * 2 + vg) * 256;
        if (nc0 <= 254) *(unsigned*)(flatV + (rowb + nc0) * 2048 + l0 * 64 + vd) = cvtpk(v0 + R.pv0[0], v1 + R.pv0[1]);
        if (nc0 >= 1) *(unsigned*)(flatV + (rowb + nc0 - 1) * 2048 + l1 * 64 + vd) = cvtpk(v0 + R.pv1[0], v1 + R.pv1[1]);
    }
    if (lane < 24) { const float z = bf2f(R.r_gate) + gb; gates[(size_t)m * 24 + lane] = 1.0f / (1.0f + __expf(-z)); }
}
#undef ROPE2
__device__ __forceinline__ void post_phase(bf16_t* __restrict__ P, const float* __restrict__ tab32, const float* __restrict__ tab64,
        const float* __restrict__ gq, const float* __restrict__ gkv, const float* __restrict__ gate_b, const float* __restrict__ posK, const float* __restrict__ posV,
        bf16_t* __restrict__ cqn, bf16_t* __restrict__ ckvn, bf16_t* __restrict__ Kmla, bf16_t* __restrict__ flatK, bf16_t* __restrict__ flatV, float* __restrict__ gates,
        int gw, int NGW, int lane) {
    const f32x4 g4 = ((const f32x4*)gq)[lane];
    const f32x2 g2 = ((const f32x2*)gkv)[lane];
    const float gb = gate_b[lane < 24 ? lane : 23];
    if (gw >= MROWS) return;
    PostRegs Rc, Rn;
    post_load(Rc, gw, lane, P, tab32, tab64, posK, posV);
    for (int m = gw; m < MROWS; m += NGW) {
        const int mn = m + NGW;
        if (mn < MROWS) post_load(Rn, mn, lane, P, tab32, tab64, posK, posV);
        post_store(Rc, m, lane, P, g4, g2, gb, cqn, ckvn, Kmla, flatK, flatV, gates);
        Rc = Rn;
    }
}

__device__ __forceinline__ v4i16_t tr_read(LAS unsigned char* p) { return __builtin_amdgcn_ds_read_tr16_b64_v4i16((LAS v4i16_t*)p); }

template <int DQK, int MODE>
__device__ __forceinline__ void attn_pass(LAS unsigned char* lds, const bf16_t* __restrict__ Qp, int qs, const bf16_t* __restrict__ Kp, int ks,
                                          const bf16_t* __restrict__ Vp, int vs, int t0, const unsigned long long* __restrict__ selp, f32x16 (&o)[2], float& linv, const int wave0) {
    constexpr int NDS = DQK / 16, CPR = DQK / 8, KSL = CPR * 1024, VSL = 8192, SLOT = KSL + VSL, NKW = (CPR > 8) ? 2 : 1;
    static_assert(3 * SLOT <= 65536, "ring fits below the accumulator park area");
    const int tid = make_tid(wave0), lane = tid & 63, r32 = lane & 31, hi = lane >> 5;
    const int wid = wave0;
    const int tw0 = t0 + 32 * wid, tq = tw0 + r32;
    bf16x8 qf[NDS];
#pragma unroll
    for (int ds = 0; ds < NDS; ++ds) qf[ds] = *(const bf16x8*)(Qp + (size_t)tq * qs + 16 * ds + 8 * hi);
    int kt_lo = 0; const int kt_hi = (t0 >> 6) + 3;
    if (MODE == 1) { const int lo = t0 - 511; kt_lo = lo > 0 ? (lo >> 6) : 0; }
    unsigned long long selm = 0ull; if (MODE == 2) selm = selp[tq];
    const int kc0 = wid % CPR, kc1 = (8 + (wid & 3)) % CPR;
    const bf16_t* ksrc0 = Kp + (size_t)lane * ks + kc0 * 8;
    const bf16_t* ksrc1 = Kp + (size_t)lane * ks + kc1 * 8;
    const bf16_t* vsrc = Vp + (size_t)(16 * (wid & 3) + (lane >> 2)) * vs + (wid >> 2) * 32 + (lane & 3) * 8;
#define AT_CL(t) ((t) < kt_hi ? (t) : kt_hi)
#define AT_DMAK(t) do { const int t_ = AT_CL(t); LAS unsigned char* d_ = lds + (t_ % 3) * SLOT; \
        __builtin_amdgcn_global_load_lds((const GAS unsigned*)(ksrc0 + (size_t)t_ * 64 * ks), (LAS unsigned*)(d_ + kc0 * 1024), 16, 0, 0); \
        if (NKW > 1) __builtin_amdgcn_global_load_lds((const GAS unsigned*)(ksrc1 + (size_t)t_ * 64 * ks), (LAS unsigned*)(d_ + kc1 * 1024), 16, 0, 0); } while (0)
#define AT_DMAV(t) do { const int t_ = AT_CL(t); LAS unsigned char* d_ = lds + (t_ % 3) * SLOT + KSL; \
        __builtin_amdgcn_global_load_lds((const GAS unsigned*)(vsrc + (size_t)t_ * 64 * vs), (LAS unsigned*)(d_ + wid * 1024), 16, 0, 0); } while (0)
#define AT_WAITBAR(N) asm volatile("s_waitcnt vmcnt(" #N ") lgkmcnt(0)\n\ts_barrier" ::: "memory")
#define AT_KFRAG(t) do { \
        LAS unsigned char* Kb_ = lds + ((t) % 3) * SLOT + hi * 1024 + r32 * 16; \
        _Pragma("unroll") for (int ds = 0; ds < NDS; ++ds) { kf[2 * ds] = *(LAS bf16x8*)(Kb_ + ds * 2048); kf[2 * ds + 1] = *(LAS bf16x8*)(Kb_ + ds * 2048 + 512); } } while (0)
#define AT_QKM(P0, P1, BIAS) do { \
        P0 = __builtin_amdgcn_mfma_f32_32x32x16_bf16(kf[0], qf[0], BIAS, 0, 0, 0); \
        P1 = __builtin_amdgcn_mfma_f32_32x32x16_bf16(kf[1], qf[0], BIAS, 0, 0, 0); \
        _Pragma("unroll") for (int ds = 1; ds < NDS; ++ds) { \
            P0 = __builtin_amdgcn_mfma_f32_32x32x16_bf16(kf[2 * ds], qf[ds], P0, 0, 0, 0); \
            P1 = __builtin_amdgcn_mfma_f32_32x32x16_bf16(kf[2 * ds + 1], qf[ds], P1, 0, 0, 0); } } while (0)
#define AT_BIAS(t) ((MODE == 2) ? ((((selm >> (t)) & 1ull) != 0ull) ? 0.f : -INFINITY) : 0.f)
#define AT_SPLAT(b) (f32x16){b, b, b, b, b, b, b, b, b, b, b, b, b, b, b, b}
    o[0] = f32x16{}; o[1] = f32x16{};
    float m_run = 0.f, l_run = 0.f; bool init = false;
    f32x16 negm = f32x16{}; asm volatile("" : "+v"(negm));
    f32x16 pa0 = f32x16{}, pa1 = f32x16{}, pb0 = f32x16{}, pb1 = f32x16{};
    bf16x8 kf[2 * NDS];
    AT_DMAK(kt_lo); AT_DMAV(kt_lo); AT_DMAK(kt_lo + 1); AT_DMAK(kt_lo + 2); AT_DMAV(kt_lo + 1);
    if (NKW > 1) AT_WAITBAR(3); else AT_WAITBAR(2);
    { AT_KFRAG(kt_lo); asm volatile("s_waitcnt lgkmcnt(0)\n\ts_barrier" ::: "memory");
      const float b_ = AT_BIAS(kt_lo); AT_QKM(pa0, pa1, AT_SPLAT(b_)); }
    const int vfo = ((lane >> 4) & 1) * 32 + (lane & 3) * 8 + (4 * hi + ((lane & 15) >> 2)) * 64;
#define AT_SB() __builtin_amdgcn_sched_barrier(0)
#define AT_VFR(dst, kk0) do { _Pragma("unroll") for (int kk = 0; kk < 2; ++kk) _Pragma("unroll") for (int dh = 0; dh < 2; ++dh) { \
            dst[(kk * 2 + dh) * 2] = tr_read(vb + dh * 4096 + ((kk0) + kk) * 1024); dst[(kk * 2 + dh) * 2 + 1] = tr_read(vb + dh * 4096 + ((kk0) + kk) * 1024 + 512); } } while (0)
#define AT_PV2(src, kk0) do { _Pragma("unroll") for (int kk = 0; kk < 2; ++kk) _Pragma("unroll") for (int dh = 0; dh < 2; ++dh) { \
            const v4i16_t lo = src[(kk * 2 + dh) * 2], hh = src[(kk * 2 + dh) * 2 + 1]; \
            const bf16x8 vf = {lo[0], lo[1], lo[2], lo[3], hh[0], hh[1], hh[2], hh[3]}; \
            o[dh] = __builtin_amdgcn_mfma_f32_32x32x16_bf16(vf, __builtin_bit_cast(bf16x8, pk[(kk0) + kk]), o[dh], 0, 0, 0); } } while (0)
#define AT_STEPF(PC0, PC1, PN0, PN1, kt) do { \
        AT_DMAK((kt) + 3); AT_DMAV((kt) + 2); \
        { bool need = (64 * (kt) + 63 > tw0); \
          if (MODE == 1) need = need || (64 * (kt) < tw0 + 31 - 511); \
          if (need) { \
              const int limh = tq - 64 * (kt) - 4 * hi; \
              const int lowh = limh - 512; \
              _Pragma("unroll") for (int r = 0; r < 16; ++r) { \
                  const int c_ = (r & 3) + 8 * (r >> 2); \
                  bool ok0 = (c_ <= limh), ok1 = (c_ + 32 <= limh); \
                  if (MODE == 1) { ok0 = ok0 && (c_ > lowh); ok1 = ok1 && (c_ + 32 > lowh); } \
                  PC0[r] = ok0 ? PC0[r] : -INFINITY; PC1[r] = ok1 ? PC1[r] : -INFINITY; } } } \
          \
        AT_KFRAG(AT_CL((kt) + 1)); \
        LAS unsigned char* vb = lds + ((kt) % 3) * SLOT + KSL + vfo; \
        asm volatile("s_nop 15\n\ts_nop 7" : "+v"(PC0), "+v"(PC1));        \
        float mx = max3f(PC0[0], PC1[0], PC0[1]), mxb = max3f(PC1[1], PC0[2], PC1[2]); \
        _Pragma("unroll") for (int r = 3; r < 15; r += 2) { mx = max3f(mx, PC0[r], PC1[r]); mxb = max3f(mxb, PC0[r + 1], PC1[r + 1]); } \
        mx = max3f(mx, PC0[15], PC1[15]); asm volatile("s_nop 1" : "+v"(mx), "+v"(mxb)); mx = fmaxf(mx, mxb); \
        mx = max32x(mx); \
        { const bool grow = init ? (mx > 8.0f) : (mx > -INFINITY);        \
          if (__any(grow)) { \
              const float dl = grow ? mx : 0.f; \
              init = init || grow; \
              m_run += dl; \
              _Pragma("unroll") for (int r = 0; r < 16; ++r) { PC0[r] -= dl; PC1[r] -= dl; } \
              const float alpha = __builtin_amdgcn_exp2f(-dl); \
              l_run *= alpha; \
              _Pragma("unroll") for (int r = 0; r < 16; ++r) { o[0][r] *= alpha; o[1][r] *= alpha; } \
              if (MODE != 2) { const float nm_ = -m_run; negm = AT_SPLAT(nm_); } } } \
        AT_SB(); \
          \
        if (MODE == 2) { const float b_ = (((selm >> AT_CL((kt) + 1)) & 1ull) != 0ull) ? -m_run : -INFINITY; AT_QKM(PN0, PN1, AT_SPLAT(b_)); } \
        else AT_QKM(PN0, PN1, negm); \
        v4i16_t va_[8], vb_[8]; \
        AT_VFR(va_, 0); \
        float ls = 0.f, lsb = 0.f; \
        _Pragma("unroll") for (int r = 0; r < 16; ++r) PC0[r] = __builtin_amdgcn_exp2f(PC0[r]); \
        asm volatile("s_nop 1" : "+v"(PC0));                                     \
        _Pragma("unroll") for (int r = 0; r < 16; r += 2) { ls = fadd_s(ls, PC0[r]); lsb = fadd_s(lsb, PC0[r + 1]); } \
        u32x4 pk[4]; \
        pk[0] = (u32x4){cvtpk(PC0[0], PC0[1]), cvtpk(PC0[2], PC0[3]), cvtpk(PC0[4], PC0[5]), cvtpk(PC0[6], PC0[7])}; \
        pk[1] = (u32x4){cvtpk(PC0[8], PC0[9]), cvtpk(PC0[10], PC0[11]), cvtpk(PC0[12], PC0[13]), cvtpk(PC0[14], PC0[15])}; \
        AT_SB(); \
          \
        AT_PV2(va_, 0); \
        AT_VFR(vb_, 2); \
        _Pragma("unroll") for (int r = 0; r < 16; ++r) PC1[r] = __builtin_amdgcn_exp2f(PC1[r]); \
        asm volatile("s_nop 1" : "+v"(PC1)); \
        _Pragma("unroll") for (int r = 0; r < 16; r += 2) { ls = fadd_s(ls, PC1[r]); lsb = fadd_s(lsb, PC1[r + 1]); } \
        pk[2] = (u32x4){cvtpk(PC1[0], PC1[1]), cvtpk(PC1[2], PC1[3]), cvtpk(PC1[4], PC1[5]), cvtpk(PC1[6], PC1[7])}; \
        pk[3] = (u32x4){cvtpk(PC1[8], PC1[9]), cvtpk(PC1[10], PC1[11]), cvtpk(PC1[12], PC1[13]), cvtpk(PC1[14], PC1[15])}; \
        asm volatile("s_nop 0" : "+v"(ls), "+v"(lsb)); \
        l_run += ls + lsb; \
        AT_SB(); \
          \
        AT_PV2(vb_, 2); \
        if (NKW > 1) AT_WAITBAR(3); else AT_WAITBAR(2); } while (0)
    for (int kt = kt_lo; kt <= kt_hi; kt += 2) {
        AT_STEPF(pa0, pa1, pb0, pb1, kt);
        if (kt + 1 <= kt_hi) AT_STEPF(pb0, pb1, pa0, pa1, kt + 1);
    }
    AT_WAITBAR(0);
#undef AT_STEPF
#undef AT_SB
#undef AT_VFR
#undef AT_PV2
#undef AT_KFRAG
#undef AT_QKM
#undef AT_BIAS
#undef AT_SPLAT
#undef AT_DMAK
#undef AT_DMAV
#undef AT_WAITBAR
#undef AT_CL
    const float lt = sum32x(l_run);
    linv = lt > 0.f ? 1.0f / lt : 0.f;
}

constexpr int OSAVE_OFF = 65536;
__device__ __forceinline__ void osave(LAS unsigned char* lds, int tid, const f32x16 (&o)[2], float sc) {
    LAS float* p = (LAS float*)(lds + OSAVE_OFF) + tid;
#pragma unroll
    for (int i = 0; i < 16; ++i) { p[i * 512] = o[0][i] * sc; p[(16 + i) * 512] = o[1][i] * sc; }
}
__device__ __forceinline__ float oload(LAS unsigned char* lds, int tid, int i) { return ((LAS float*)(lds + OSAVE_OFF) + tid)[i * 512]; }
__device__ __forceinline__ void store_o_bf16(bf16_t* dst, const f32x16 (&o)[2], int hi) {
#pragma unroll
    for (int dh = 0; dh < 2; ++dh)
#pragma unroll
        for (int ap = 0; ap < 2; ++ap) {
            const int a0 = 2 * ap, a1 = a0 + 1;
            unsigned x0 = cvtpk(o[dh][4 * a0], o[dh][4 * a0 + 1]), x1 = cvtpk(o[dh][4 * a0 + 2], o[dh][4 * a0 + 3]);
            unsigned y0 = cvtpk(o[dh][4 * a1], o[dh][4 * a1 + 1]), y1 = cvtpk(o[dh][4 * a1 + 2], o[dh][4 * a1 + 3]);
            const auto r0 = __builtin_amdgcn_permlane32_swap(x0, y0, false, false);
            const auto r1 = __builtin_amdgcn_permlane32_swap(x1, y1, false, false);
            const u32x4 w = {r0[0], r1[0], r0[1], r1[1]};
            *(u32x4*)(dst + 32 * dh + 8 * (hi ? a1 : a0)) = w;
        }
}

__device__ __forceinline__ void attn_phase(LAS unsigned char* lds, int* counter, const bf16_t* __restrict__ P, const bf16_t* __restrict__ Qm, const bf16_t* __restrict__ Kmla,
        const bf16_t* __restrict__ Vmla, const unsigned long long* __restrict__ mask, const bf16_t* __restrict__ ocmp, const float* __restrict__ gates,
        const float* __restrict__ dng, float lam, float lam_init, bf16_t* __restrict__ Omix, const int wave0) {
    LAS int* sunit = (LAS int*)(lds + MISC_OFF);
    const int wid = wave0;
    const int x0 = (int)((unsigned)__builtin_amdgcn_s_getreg((3 << 11) | 20) & 7u);
#pragma nounroll
    for (int xi = 0; xi < 8; ++xi) {
    const int bq = (x0 + xi) & 7;
    for (;;) {
        const int tid = make_tid(wave0), lane = tid & 63, r32 = lane & 31, hi = lane >> 5;
        __syncthreads();
        if (tid == 0) *sunit = atomicAdd(counter + bq, 1);
        __syncthreads();
        const int u = __builtin_amdgcn_readfirstlane(*sunit);
        if (u >= 256) break;
        int r, qb;
        if (u < 128) { qb = 15 - ((u & 63) >> 2); r = 64 + bq * 8 + (u >> 6) * 4 + (u & 3); }
        else if (u < 192) { const int v_ = u - 128; qb = 15 - ((v_ & 31) >> 1); r = 32 + bq * 4 + (v_ >> 5) * 2 + (v_ & 1); }
        else { const int v_ = u - 192; qb = 15 - ((v_ & 31) >> 1); r = bq * 4 + (v_ >> 5) * 2 + (v_ & 1); }
        const int t0 = qb * 256, tq = t0 + 32 * wid + r32;
        f32x16 o[2]; float linv;
        if (r < 32) {
            const int b = r >> 2, h = r & 3;
            const bf16_t* Pb = P + (size_t)b * SEQ * NPJ;
            attn_pass<32, 0>(lds, Pb + C_DQ + (2 * h) * 32, NPJ, Pb + C_DK + (2 * h) * 32, NPJ, Pb + C_DV + h * 64, NPJ, t0, nullptr, o, linv, wave0);
            osave(lds, tid, o, linv);
            attn_pass<32, 0>(lds, Pb + C_DQ + (2 * h + 1) * 32, NPJ, Pb + C_DK + (2 * h + 1) * 32, NPJ, Pb + C_DV + h * 64, NPJ, t0, nullptr, o, linv, wave0);
            const float l2 = lam * linv; float ss = 0.f;
#pragma unroll
            for (int i = 0; i < 16; ++i) { o[0][i] = oload(lds, tid, i) - l2 * o[0][i]; o[1][i] = oload(lds, tid, 16 + i) - l2 * o[1][i]; ss += o[0][i] * o[0][i] + o[1][i] * o[1][i]; }
            ss = sum32x(ss);
            const float rs = (1.0f / sqrtf(ss * (1.0f / 64) + EPS)) * (1.0f - lam_init);
#pragma unroll
            for (int dh = 0; dh < 2; ++dh)
#pragma unroll
                for (int a = 0; a < 4; ++a) { const f32x4 g4 = *(const f32x4*)(dng + 32 * dh + 8 * a + 4 * hi);
#pragma unroll
                    for (int j = 0; j < 4; ++j) o[dh][4 * a + j] *= rs * g4[j]; }
            store_o_bf16(Omix + (size_t)(b * SEQ + tq) * DM + 256 + h * 64, o, hi);
        } else if (r < 64) {
            const int b = (r - 32) >> 2, h = (r - 32) & 3;
            const size_t rb = (size_t)b * SEQ;
            attn_pass<96, 0>(lds, Qm + rb * 384 + h * 96, 384, Kmla + rb * 384 + h * 96, 384, Vmla + rb * 256 + h * 64, 256, t0, nullptr, o, linv, wave0);
#pragma unroll
            for (int i = 0; i < 16; ++i) { o[0][i] *= linv; o[1][i] *= linv; }
            store_o_bf16(Omix + (rb + tq) * DM + h * 64, o, hi);
        } else {
            const int b = (r - 64) >> 3, head = (r - 64) & 7, g = head >> 2;
            const bf16_t* Pb = P + (size_t)b * SEQ * NPJ;
            attn_pass<64, 2>(lds, Pb + C_NQ + head * 64, NPJ, Pb + C_NKV + 256 + g * 64, NPJ, Pb + C_NKV + 384 + g * 64, NPJ, t0, mask + (size_t)(b * 2 + g) * SEQ, o, linv, wave0);
            const size_t row = (size_t)b * SEQ + tq;
            osave(lds, tid, o, linv * gates[row * 24 + head * 3 + 1]);
            attn_pass<64, 1>(lds, Pb + C_NQ + head * 64, NPJ, Pb + C_NKV + 512 + g * 64, NPJ, Pb + C_NKV + 640 + g * 64, NPJ, t0, nullptr, o, linv, wave0);
            const float g0 = gates[row * 24 + head * 3 + 0], sc2 = linv * gates[row * 24 + head * 3 + 2];
            const bf16_t* oc = ocmp + row * 512 + head * 64;
#pragma unroll
            for (int dh = 0; dh < 2; ++dh)
#pragma unroll
                for (int a = 0; a < 4; ++a) {
                    const u32x2 raw = *(const u32x2*)(oc + 32 * dh + 8 * a + 4 * hi);
                    const float c0 = __uint_as_float(raw.x << 16), c1 = __uint_as_float(raw.x & 0xffff0000u), c2 = __uint_as_float(raw.y << 16), c3 = __uint_as_float(raw.y & 0xffff0000u);
                    o[dh][4 * a + 0] = o[dh][4 * a + 0] * sc2 + oload(lds, tid, 16 * dh + 4 * a + 0) + g0 * c0;
                    o[dh][4 * a + 1] = o[dh][4 * a + 1] * sc2 + oload(lds, tid, 16 * dh + 4 * a + 1) + g0 * c1;
                    o[dh][4 * a + 2] = o[dh][4 * a + 2] * sc2 + oload(lds, tid, 16 * dh + 4 * a + 2) + g0 * c2;
                    o[dh][4 * a + 3] = o[dh][4 * a + 3] * sc2 + oload(lds, tid, 16 * dh + 4 * a + 3) + g0 * c3;
                }
            store_o_bf16(Omix + row * DM + 512 + head * 64, o, hi);
        }
    }
    }
}

__device__ __forceinline__ void cmp_phase(LAS unsigned char* lds, const bf16_t* __restrict__ P, const bf16_t* __restrict__ Kc, const bf16_t* __restrict__ Vc,
                                          bf16_t* __restrict__ ocmp, unsigned long long* __restrict__ mask, int G, const int wave0) {
    constexpr int KSTR = 144, VOFFC = 256 * KSTR;
    const int wid = wave0;
    for (int unit = opaque_bid(); unit < 256; unit += G) {
        const int tid = make_tid(wave0), lane = tid & 63, r32 = lane & 31, hi = lane >> 5;
        const int b = unit >> 5, g = (unit >> 4) & 1, kq = (unit >> 1) & 7, hq = unit & 1, bg = b * 2 + g;
        const int qb = (wid < 4) ? (15 - kq) : kq;
        __syncthreads();
#pragma unroll
        for (int i = 0; i < 4; ++i) {
            const int c = tid + 512 * i, row = c >> 3, ch = c & 7;
            const u32x4 kv = *(const u32x4*)(Kc + (size_t)(bg * 256 + row) * 64 + ch * 8);
            const u32x4 vv = *(const u32x4*)(Vc + (size_t)(bg * 256 + row) * 64 + ch * 8);
            *(LAS u32x4*)(lds + row * KSTR + ch * 16) = kv;
            *(LAS u32x4*)(lds + VOFFC + (ch >> 2) * 16384 + row * 64 + (ch & 3) * 16) = vv;
        }
        __syncthreads();
        const int tw0 = qb * 256 + hq * 128 + 32 * (wid & 3), tq = tw0 + r32;
        const int nch = ((tw0 >> 4) >> 6) + 1;
        const size_t row = (size_t)b * SEQ + tq;
        LAS float* mi = (LAS float*)(lds + MI_OFF + wid * 1024);
        LAS float* sc = (LAS float*)(lds + SC_OFF + wid * (32 * 65 * 4) + r32 * (65 * 4));
#define CMP_QK(c_) \
                f32x16 p0 = f32x16{}, p1 = f32x16{}; \
                _Pragma("unroll") for (int ds = 0; ds < 4; ++ds) { \
                    const bf16x8 ka = *(LAS bf16x8*)(lds + (64 * (c_) + r32) * KSTR + ds * 32 + hi * 16); \
                    const bf16x8 kb = *(LAS bf16x8*)(lds + (64 * (c_) + 32 + r32) * KSTR + ds * 32 + hi * 16); \
                    p0 = __builtin_amdgcn_mfma_f32_32x32x16_bf16(ka, qf[ds], p0, 0, 0, 0); \
                    p1 = __builtin_amdgcn_mfma_f32_32x32x16_bf16(kb, qf[ds], p1, 0, 0, 0); }
#pragma nounroll
        for (int hh = 0; hh < 4; ++hh) {
            const int head = 4 * g + hh;
            bf16x8 qf[4];
#pragma unroll
            for (int ds = 0; ds < 4; ++ds) qf[ds] = *(const bf16x8*)(P + row * NPJ + C_NQ + head * 64 + 16 * ds + 8 * hi);
            float m_run = -1e30f, l_run = 0.f;
#pragma nounroll
            for (int c = 0; c < nch; ++c) {
                CMP_QK(c)
                if (16 * (64 * c + 63) + 31 > tw0) {
#pragma unroll
                    for (int r = 0; r < 16; ++r) {
                        const int nc = 64 * c + crow(r, hi);
                        p0[r] = (16 * nc + 31 <= tq) ? p0[r] : -INFINITY; p1[r] = (16 * (nc + 32) + 31 <= tq) ? p1[r] : -INFINITY;
                    }
                }
                asm volatile("s_nop 15\n\ts_nop 7" : "+v"(p0), "+v"(p1));
                float mx = max3f(p0[0], p1[0], p0[1]);
#pragma unroll
                for (int r = 1; r < 16; ++r) mx = max3f(mx, p0[r], p1[r]);
                asm volatile("s_nop 1" : "+v"(mx));
                mx = fmaxf(mx, mx);
                mx = max32x(mx);
                const float m_new = fmaxf(m_run, mx);
                float ls = 0.f;
#pragma unroll
                for (int r = 0; r < 16; ++r) ls += __builtin_amdgcn_exp2f(p0[r] - m_new) + __builtin_amdgcn_exp2f(p1[r] - m_new);
                l_run = l_run * __builtin_amdgcn_exp2f(m_run - m_new) + ls;
                m_run = m_new;
            }
            const float lt = sum32x(l_run);
            const float inv = lt > 0.f ? 1.0f / lt : 0.f;
            if (hi == 0) { mi[(hh * 32 + r32) * 2] = m_run; mi[(hh * 32 + r32) * 2 + 1] = inv; }
            f32x16 o[2]; o[0] = f32x16{}; o[1] = f32x16{};
#pragma nounroll
            for (int c = 0; c < nch; ++c) {
                CMP_QK(c)
                if (16 * (64 * c + 63) + 31 > tw0) {
#pragma unroll
                    for (int r = 0; r < 16; ++r) {
                        const int nc = 64 * c + crow(r, hi);
                        p0[r] = (16 * nc + 31 <= tq) ? p0[r] : -INFINITY; p1[r] = (16 * (nc + 32) + 31 <= tq) ? p1[r] : -INFINITY;
                    }
                }
#pragma unroll
                for (int r = 0; r < 16; ++r) { p0[r] = __builtin_amdgcn_exp2f(p0[r] - m_run) * inv; p1[r] = __builtin_amdgcn_exp2f(p1[r] - m_run) * inv; }
                u32x4 pk[4];
                pk[0] = (u32x4){cvtpk(p0[0], p0[1]), cvtpk(p0[2], p0[3]), cvtpk(p0[4], p0[5]), cvtpk(p0[6], p0[7])};
                pk[1] = (u32x4){cvtpk(p0[8], p0[9]), cvtpk(p0[10], p0[11]), cvtpk(p0[12], p0[13]), cvtpk(p0[14], p0[15])};
                pk[2] = (u32x4){cvtpk(p1[0], p1[1]), cvtpk(p1[2], p1[3]), cvtpk(p1[4], p1[5]), cvtpk(p1[6], p1[7])};
                pk[3] = (u32x4){cvtpk(p1[8], p1[9]), cvtpk(p1[10], p1[11]), cvtpk(p1[12], p1[13]), cvtpk(p1[14], p1[15])};
                LAS unsigned char* vb = lds + VOFFC + (64 * c) * 64 + ((lane >> 4) & 1) * 32 + (lane & 3) * 8 + (4 * hi + ((lane & 15) >> 2)) * 64;
#pragma unroll
                for (int dh = 0; dh < 2; ++dh)
#pragma unroll
                    for (int kk = 0; kk < 4; ++kk) {
                        const v4i16_t lo = tr_read(vb + dh * 16384 + kk * 1024), hh2 = tr_read(vb + dh * 16384 + kk * 1024 + 512);
                        const bf16x8 vf = {lo[0], lo[1], lo[2], lo[3], hh2[0], hh2[1], hh2[2], hh2[3]};
                        o[dh] = __builtin_amdgcn_mfma_f32_32x32x16_bf16(vf, __builtin_bit_cast(bf16x8, pk[kk]), o[dh], 0, 0, 0);
                    }
            }
            store_o_bf16(ocmp + row * 512 + head * 64, o, hi);
            asm volatile("" ::: "memory");
        }
        const int cblk = tq >> 6;
        float carry = 0.f;
#pragma nounroll
        for (int c = 0; c < 4; ++c) {
            float A8[8], B8[8];
#pragma unroll
            for (int k = 0; k < 8; ++k) { A8[k] = 0.f; B8[k] = 0.f; }
            if (c < nch) {
#pragma nounroll
                for (int hh = 0; hh < 4; ++hh) {
                    const int head = 4 * g + hh;
                    bf16x8 qf[4];
#pragma unroll
                    for (int ds = 0; ds < 4; ++ds) qf[ds] = *(const bf16x8*)(P + row * NPJ + C_NQ + head * 64 + 16 * ds + 8 * hi);
                    CMP_QK(c)
                    const float m_h = mi[(hh * 32 + r32) * 2], i_h = mi[(hh * 32 + r32) * 2 + 1];
                    if (16 * (64 * c + 63) + 31 > tw0) {
#pragma unroll
                        for (int r = 0; r < 16; ++r) {
                            const int nc = 64 * c + crow(r, hi);
                            p0[r] = (16 * nc + 31 <= tq) ? p0[r] : -INFINITY; p1[r] = (16 * (nc + 32) + 31 <= tq) ? p1[r] : -INFINITY;
                        }
                    }
#pragma unroll
                    for (int r = 0; r < 16; ++r) { p0[r] = __builtin_amdgcn_exp2f(p0[r] - m_h) * i_h; p1[r] = __builtin_amdgcn_exp2f(p1[r] - m_h) * i_h; }
#pragma unroll
                    for (int k = 0; k < 4; ++k) {
                        A8[k] += p0[4 * k] + 2.0f * (p0[4 * k + 1] + p0[4 * k + 2] + p0[4 * k + 3]); B8[k] += p0[4 * k];
                        A8[4 + k] += p1[4 * k] + 2.0f * (p1[4 * k + 1] + p1[4 * k + 2] + p1[4 * k + 3]); B8[4 + k] += p1[4 * k];
                    }
                }
            }
            float pa[8];
#pragma unroll
            for (int k = 0; k < 8; ++k) pa[k] = partner32(A8[k], hi);
#pragma unroll
            for (int k = 0; k < 8; ++k) {
                const int i = 8 * c + k, j = 2 * i + hi;
                const float ap = hi ? pa[k] : (k > 0 ? pa[k - 1] : carry);
                const float ps = B8[k] + ap;
                const bool forced = (j == 0) || (j == cblk) || (j == cblk - 1);
                sc[j] = (j > cblk) ? -1.0f : (ps + (forced ? 1e4f : 0.f));
            }
            carry = pa[7];
        }
#undef CMP_QK
        asm volatile("" ::: "memory");
        {
            float s[32];
#pragma unroll
            for (int i = 0; i < 32; ++i) s[i] = sc[2 * i + hi];
            int rank[32];
#pragma unroll
            for (int i = 0; i < 32; ++i) rank[i] = 0;
            const int kmax = ((tw0 + 31) >> 6) + 1;
#pragma nounroll
            for (int k = 0; k < kmax; ++k) {
                const float sk = sc[k];
                const int kk = k - hi;
#pragma unroll
                for (int i = 0; i < 32; ++i) rank[i] += ((sk > s[i]) || ((sk == s[i]) && (kk < 2 * i))) ? 1 : 0;
            }
            unsigned mlo = 0u, mhi = 0u;
#pragma unroll
            for (int i = 0; i < 32; ++i) {
                const unsigned bit = (rank[i] < 16) ? 1u : 0u;
                if (i < 16) mlo |= bit << (2 * i + hi); else mhi |= bit << (2 * (i - 16) + hi);
            }
            mlo = or32x(mlo); mhi = or32x(mhi);
            if (hi == 0) mask[(size_t)bg * SEQ + tq] = ((unsigned long long)mhi << 32) | (unsigned long long)mlo;
        }
    }
}

typedef unsigned short bf16;
#define XB_TMO      128
#define XB_XCNT(j)  (256  + 64 * (j))
#define XB_XSUB(j)  (1280 + 64 * (j))
#define XB_XGEN(j)  (2304 + 64 * (j))
#define XB_TOP      3328
#define XB_TOPGEN   3392
#define XCD_BAR_WORDS 3456
#define XB_SPIN_CAP (1u << 18)

__device__ __forceinline__ unsigned xb_ld(unsigned* p)              { return __hip_atomic_load(p, __ATOMIC_RELAXED, __HIP_MEMORY_SCOPE_AGENT); }
__device__ __forceinline__ unsigned xb_add(unsigned* p, unsigned v) { return __hip_atomic_fetch_add(p, v, __ATOMIC_RELAXED, __HIP_MEMORY_SCOPE_AGENT); }
__device__ __forceinline__ unsigned xb_xcc_id() { return (unsigned)__builtin_amdgcn_s_getreg((3 << 11) | 20) & 0xFu; }
#define XB_SPIN(cond, bar) do { unsigned _sp = 0; while (cond) { __builtin_amdgcn_s_sleep(1); \
    if ((++_sp & 255u) == 0u) { if (xb_ld(&(bar)[XB_TMO])) break; if (_sp > XB_SPIN_CAP) { atomicAdd(&(bar)[XB_TMO], 1u); break; } } } } while (0)

struct XcdBarrier {
    unsigned* bar; unsigned x;
    volatile LAS unsigned* st;
};

__device__ __forceinline__ XcdBarrier xcd_barrier_post(unsigned* bar, volatile LAS unsigned* st) {
    XcdBarrier b; b.bar = bar; b.x = xb_xcc_id(); b.st = st;
    if (threadIdx.x == 0) (void)xb_add(&bar[XB_XCNT(b.x)], 1u);
    return b;
}
__device__ __forceinline__ void xcd_barrier_complete(unsigned* bar, unsigned x, unsigned& nloc, unsigned& nx) {
    const unsigned G = gridDim.x * gridDim.y * gridDim.z;
    unsigned sum, cnt, mine, sp = 0u;
    for (;;) {
        sum = 0u; cnt = 0u; mine = 0u;
#pragma unroll
        for (unsigned j = 0; j < 16; ++j) { const unsigned c = xb_ld(&bar[XB_XCNT(j)]); sum += c; cnt += (c > 0u) ? 1u : 0u; mine = (j == x) ? c : mine; }
        if (sum == G) break;
        __builtin_amdgcn_s_sleep(1);
        if ((++sp & 255u) == 0u) { if (xb_ld(&bar[XB_TMO])) break; if (sp > XB_SPIN_CAP) { atomicAdd(&bar[XB_TMO], 1u); break; } }
    }
    nloc = mine > 0u ? mine : 1u; nx = cnt > 0u ? cnt : 1u;
}

__device__ __forceinline__ void xcd_barrier(const XcdBarrier& b) {
    asm volatile("s_waitcnt vmcnt(0)" ::: "memory");
    __syncthreads();
    if (threadIdx.x == 0) {
        unsigned* bar = b.bar;
        __builtin_amdgcn_s_waitcnt(0);
        unsigned nloc = b.st[0], nx = b.st[1];
        if (nloc == 0u) { xcd_barrier_complete(bar, b.x, nloc, nx); b.st[0] = nloc; b.st[1] = nx; }
        const unsigned old = xb_add(&bar[XB_XSUB(b.x)], 1u);
        const unsigned gen = old / nloc;
        if (old + 1u == (gen + 1u) * nloc) {
            __builtin_amdgcn_fence(__ATOMIC_RELEASE, "agent");
            asm volatile("s_waitcnt vmcnt(0)" ::: "memory");
            const unsigned og = xb_add(&bar[XB_TOP], 1u);
            const unsigned tg = og / nx;
            if (og + 1u == (tg + 1u) * nx) xb_add(&bar[XB_TOPGEN], 1u);
            else XB_SPIN(xb_ld(&bar[XB_TOPGEN]) == tg, bar);
            __builtin_amdgcn_fence(__ATOMIC_ACQUIRE, "agent");
            xb_add(&bar[XB_XGEN(b.x)], 1u);
            asm volatile("s_waitcnt vmcnt(0)" ::: "memory");
        } else {
            XB_SPIN(xb_ld(&bar[XB_XGEN(b.x)]) == gen, bar);
            __builtin_amdgcn_fence(__ATOMIC_ACQUIRE, "agent");
            asm volatile("s_waitcnt vmcnt(0)" ::: "memory");
        }
    }
    __syncthreads();
}

__device__ __forceinline__ void convert_layer(int l, const float* w_gate, const float* w_up, const float* w_down, const float* ffn_g, const float* w_in, const float* mix_g,
                                              const float* w_out, const float* w_uq, const float* w_ukv, const float* w1, const float* w2,
                                              unsigned char* ws, LAS float* scr, int gw, int NGW, int lane) {
#pragma nounroll
    for (int f = 0; f < 2; ++f) {
        const int lf = l * 2 + f; const size_t wo = (size_t)lf * DM * FF;
        transpose_mat(w_gate + wo, DM, FF, FF, (bf16_t*)(ws + WS_WGU + lf * SZ_WGU), 256, 0, scr, gw, NGW, lane, ffn_g + (size_t)lf * DM);
        transpose_mat(w_up + wo, DM, FF, FF, (bf16_t*)(ws + WS_WGU + lf * SZ_WGU), 256, 128, scr, gw, NGW, lane, ffn_g + (size_t)lf * DM);
        transpose_mat(w_down + wo, FF, DM, DM, (bf16_t*)(ws + WS_WD + lf * SZ_WD), 128, 0, scr, gw, NGW, lane);
    }
    transpose_mat(w_in + (size_t)l * DM * NIN, DM, NIN, NPJ, (bf16_t*)(ws + WS_WIN + l * SZ_WIN), 128, 0, scr, gw, NGW, lane, mix_g + (size_t)l * DM);
    transpose_mat(w_out + (size_t)l * DM * DM, DM, DM, DM, (bf16_t*)(ws + WS_WOUT + l * SZ_WOUT), 128, 0, scr, (gw + 512) % NGW, NGW, lane);
    transpose_mat(w_uq + (size_t)l * 256 * 384, 256, 384, 512, (bf16_t*)(ws + WS_WUQ + l * SZ_WUQ), 128, 0, scr, (gw + 1024) % NGW, NGW, lane);
    transpose_mat(w_ukv + (size_t)l * 128 * 512, 128, 512, 512, (bf16_t*)(ws + WS_WUKV + l * SZ_WUKV), 128, 0, scr, (gw + 1200) % NGW, NGW, lane);
#pragma nounroll
    for (int kv = 0; kv < 2; ++kv) {
        transpose_mat(w1 + (size_t)(l * 2 + kv) * 2048 * 256, 2048, 256, 256, (bf16_t*)(ws + WS_W1 + (l * 2 + kv) * SZ_W1), 128, 0, scr, (gw + 1400 + 100 * kv) % NGW, NGW, lane);
        transpose_mat(w2 + (size_t)(l * 2 + kv) * 256 * 64, 256, 64, 256, (bf16_t*)(ws + WS_W2 + (l * 2 + kv) * SZ_W2), 128, 0, scr, (gw + 1600 + 40 * kv) % NGW, NGW, lane);
    }
}

struct KArgs { const float* in[20]; float* out; unsigned char* ws; };

#define PIN(i) ((const float*)(*(const GAS float* const*)(ws + WS_PTAB + 8 * (i))))
#define POUT ((float*)(*(GAS float* const*)(ws + WS_PTAB + 8 * 20)))
__device__ __forceinline__ GemmDesc make_gemm(int id, int l, int f, unsigned char* ws) {
    GemmDesc d; d.M = MROWS; d.rot = 0;
    d.e.kind = EK_BF16; d.e.fin = nullptr; d.e.fout = nullptr; d.e.o0 = nullptr; d.e.o1 = nullptr; d.e.aux = nullptr; d.e.ldc = 0; d.e.ncols = 0; d.e.flags = 0; d.e.coef = 0.f; d.e.pad = 0;
    bf16_t* hn = (bf16_t*)(ws + WS_HN); bf16_t* act = (bf16_t*)(ws + WS_ACT);
    switch (id) {
    case 0:
        d.A = f ? (const bf16_t*)(ws + WS_HN2) : hn; d.Bt = (const bf16_t*)(ws + WS_WGU + (size_t)(l * 2 + f) * SZ_WGU); d.N = 2 * FF; d.K = DM;
        d.e.kind = EK_ACT; d.e.o0 = (GAS bf16_t*)(act); d.e.ldc = FF; d.e.fin = (const GAS float*)(ws + WS_SS + (size_t)(l * 3 + (f ? 2 : 0)) * MROWS * 4); break;
    case 1:
        d.A = act; d.Bt = (const bf16_t*)(ws + WS_WD + (size_t)(l * 2 + f) * SZ_WD); d.N = DM; d.K = FF;
        d.e.kind = EK_RES; d.e.fin = (const GAS float*)((l == 0 && f == 0) ? PIN(0) : (const float*)POUT); d.e.fout = (GAS float*)(POUT); d.e.ldc = DM; d.e.coef = 0.5f;
        if (!(l == 1 && f == 1)) { d.e.flags = 2; d.e.o0 = (GAS bf16_t*)(hn); d.e.o1 = (GAS bf16_t*)(ws + WS_SS + (size_t)(f ? (l + 1) * 3 : l * 3 + 1) * MROWS * 4); }
        break;
    case 2:
        d.A = hn; d.Bt = (const bf16_t*)(ws + WS_WIN + (size_t)l * SZ_WIN); d.N = NPJ; d.K = DM;
        d.e.kind = EK_BF16; d.e.o0 = (GAS bf16_t*)(act); d.e.ldc = NPJ; d.e.ncols = NIN; d.e.flags = 4; d.e.fin = (const GAS float*)(ws + WS_SS + (size_t)(l * 3 + 1) * MROWS * 4); break;
    case 3:
        d.A = (const bf16_t*)(ws + WS_CQN); d.Bt = (const bf16_t*)(ws + WS_WUQ + (size_t)l * SZ_WUQ); d.N = 512; d.K = 256;
        d.e.kind = EK_QUP; d.e.o0 = (GAS bf16_t*)((bf16_t*)(ws + WS_QM)); d.e.aux = (const GAS float*)((const float*)(ws + WS_TAB32)); break;
    case 4:
        d.A = (const bf16_t*)(ws + WS_CKVN); d.Bt = (const bf16_t*)(ws + WS_WUKV + (size_t)l * SZ_WUKV); d.N = 512; d.K = 128;
        d.e.kind = EK_KVUP; d.e.o0 = (GAS bf16_t*)((bf16_t*)(ws + WS_KMLA)); d.e.o1 = (GAS bf16_t*)((bf16_t*)(ws + WS_VMLA)); break;
    case 5: case 6: {
        const int kv = id - 5;
        d.M = 4096; d.A = (const bf16_t*)(ws + (kv ? WS_FLATV : WS_FLATK)); d.Bt = (const bf16_t*)(ws + WS_W1 + (size_t)(l * 2 + kv) * SZ_W1); d.N = 256; d.K = 2048; d.rot = 16 + 16 * kv;
        d.e.kind = EK_BF16; d.e.o0 = (GAS bf16_t*)((bf16_t*)(ws + (kv ? WS_HIDV : WS_HIDK))); d.e.ldc = 256; d.e.ncols = 256; d.e.flags = 1; d.e.aux = (const GAS float*)(PIN(15) + (size_t)(l * 2 + kv) * 256); break; }
    case 7: case 8: {
        const int kv = id - 7;
        d.M = 4096; d.A = (const bf16_t*)(ws + (kv ? WS_HIDV : WS_HIDK)); d.Bt = (const bf16_t*)(ws + WS_W2 + (size_t)(l * 2 + kv) * SZ_W2); d.N = 256; d.K = 256; d.rot = 16 * kv;
        d.e.kind = EK_BF16; d.e.o0 = (GAS bf16_t*)((bf16_t*)(ws + (kv ? WS_VC : WS_KC))); d.e.ldc = 64; d.e.ncols = 64; break; }
    default:
        d.A = hn; d.Bt = (const bf16_t*)(ws + WS_WOUT + (size_t)l * SZ_WOUT); d.N = DM; d.K = DM;
        d.e.kind = EK_RES; d.e.fin = (const GAS float*)(POUT); d.e.fout = (GAS float*)(POUT); d.e.ldc = DM; d.e.coef = 1.0f;
        d.e.flags = 2; d.e.o0 = (GAS bf16_t*)(ws + WS_HN2); d.e.o1 = (GAS bf16_t*)(ws + WS_SS + (size_t)(l * 3 + 2) * MROWS * 4); break;
    }
    return d;
}

__global__ void __launch_bounds__(NTHR, 2) hymba_fwd(KArgs a) {
    extern __shared__ __attribute__((aligned(16))) unsigned char lds_raw[];
    LAS unsigned char* lds = (LAS unsigned char*)lds_raw;
    cg::grid_group grid = cg::this_grid();
    const int G = gridDim.x, NGW = G * 8;
    const int wave0 = __builtin_amdgcn_readfirstlane((int)threadIdx.x >> 6);
    if (threadIdx.x < 64) ((LAS unsigned*)(lds + MISC_OFF))[threadIdx.x] = 0u;
    __syncthreads();
    unsigned char* const ws0 = a.ws;

#ifdef PROBE_PRO2
#pragma nounroll
    for (int rep_ = 0; rep_ < 2; ++rep_)
#endif
    {
        const int tid = threadIdx.x, lane = tid & 63, wave = __builtin_amdgcn_readfirstlane(tid >> 6);
        const int gw = blockIdx.x * 8 + wave;
        unsigned char* ws = ws0;
        int* ctl = (int*)(ws + WS_CTL);
        float* ctlf = (float*)(ws + WS_CTL + 256);
        float* tab32 = (float*)(ws + WS_TAB32);
        float* tab64 = (float*)(ws + WS_TAB64);
        LAS float* scr = (LAS float*)(lds + wave * 16384);
        convert_layer(0, a.in[2], a.in[3], a.in[4], a.in[1], a.in[6], a.in[5], a.in[18], a.in[8], a.in[10], a.in[14], a.in[16], ws, scr, gw, NGW, lane);
        const int gtid = blockIdx.x * NTHR + tid, NT = G * NTHR;
        {
            bf16_t* hn = (bf16_t*)(ws + WS_HN); float* ss = (float*)(ws + WS_SS);
#pragma unroll 2
            for (int m = gw; m < MROWS; m += NGW) {
                const f32x4* xr = (const f32x4*)(a.in[0] + (size_t)m * DM) + lane; float sq = 0.f;
                u32x2* o8 = (u32x2*)(hn + (size_t)m * DM) + lane;
                f32x4 v[4];
#pragma unroll
                for (int j = 0; j < 4; ++j) v[j] = __builtin_nontemporal_load(xr + 64 * j);
#pragma unroll
                for (int j = 0; j < 4; ++j) { sq += (v[j][0] * v[j][0] + v[j][1] * v[j][1]) + (v[j][2] * v[j][2] + v[j][3] * v[j][3]); u32x2 w; w.x = cvtpk(v[j][0], v[j][1]); w.y = cvtpk(v[j][2], v[j][3]); o8[64 * j] = w; }
                sq = wave_sum(sq); if (lane == 0) ss[m] = sq;
            }
            for (int e = gtid; e < 5 * MROWS; e += NT) ss[MROWS + e] = 0.f;
        }
        for (int e = gtid; e < SEQ * 16; e += NT) {
            const int t = e >> 4, i = e & 15; double p = 1.0; for (int k = 0; k < i; ++k) p *= 0.5623413251903491;
            float c, s; sincos_acc((float)t * (float)p, c, s); tab32[2 * e] = c; tab32[2 * e + 1] = s;
        }
        for (int e = gtid; e < SEQ * 32; e += NT) {
            const int t = e >> 5, i = e & 31; double p = 1.0; for (int k = 0; k < i; ++k) p *= 0.7498942093324558;
            float c, s; sincos_acc((float)t * (float)p, c, s); tab64[2 * e] = c; tab64[2 * e + 1] = s;
        }
        for (int e = gtid; e < 2 * 16 * 256; e += NT) {
            const int which = e >> 12, r = (e >> 8) & 15, ch = e & 255;
            bf16_t* base = (bf16_t*)(ws + (which ? WS_FLATV : WS_FLATK)) + ((size_t)(r * 256 + 255)) * 2048 + ch * 8;
            *(u32x4*)base = (u32x4){0u, 0u, 0u, 0u};
        }
        if (blockIdx.x == 0) { unsigned* bw = (unsigned*)(ws + WS_BAR); for (int i = tid; i < XCD_BAR_WORDS; i += NTHR) bw[i] = 0u; }
        if (gtid == 0) {
            for (int i = 0; i < 20; ++i) *(const float**)(ws + WS_PTAB + 8 * i) = a.in[i];
            *(float**)(ws + WS_PTAB + 8 * 20) = a.out;
            EpiP* et = (EpiP*)(ws + WS_CTL + 1024);
            for (int l = 0; l < 2; ++l)
                for (int sl = 0; sl < 12; ++sl) { const GemmDesc d = make_gemm(sl < 10 ? sl : sl - 10, l, sl < 10 ? 0 : 1, ws); et[l * 12 + sl] = d.e; }
            for (int i = 0; i < 32; ++i) ctl[i] = 0;
            for (int l = 0; l < 2; ++l) {
                const float* lf = a.in[11] + l * 128; float s1 = 0.f, s2 = 0.f;
                for (int i = 0; i < 32; ++i) { s1 += lf[i] * lf[32 + i]; s2 += lf[64 + i] * lf[96 + i]; }
                const float li = (l == 0) ? 0.2f : 0.35550906759096934f;
                ctlf[2 * l] = expf(s1) - expf(s2) + li; ctlf[2 * l + 1] = li;
            }
        }
    }
    asm volatile("s_waitcnt vmcnt(0)" ::: "memory");
    grid.sync();
    (void)xcd_barrier_post((unsigned*)(ws0 + WS_BAR), (volatile LAS unsigned*)(lds + MISC_OFF) + 8);
#define GRID_BAR() do { XcdBarrier xb_; xb_.bar = (unsigned*)(ws0 + WS_BAR); xb_.x = xb_xcc_id(); xb_.st = (volatile LAS unsigned*)(lds + MISC_OFF) + 8; xcd_barrier(xb_); } while (0)

#ifdef PROBE_MASK
    int rep_ = 0;
#endif
#pragma nounroll
    for (int it = 0; it < 28; ++it) {
        GAS unsigned char* wsg_; asm volatile("s_mov_b64 %0, %1" : "=s"(wsg_) : "s"(ws0)); unsigned char* ws = (unsigned char*)wsg_;
        const int wave = wave0, bid = opaque_bid();
#define LANEV() (make_tid(wave0) & 63)
        const int gw = bid * 8 + wave;
        const int l = it / 14, s = it % 14;
        int gid0 = 0, ng = 0, f = 0;
        bf16_t* hn = (bf16_t*)(ws + WS_HN);
        bf16_t* P = (bf16_t*)(ws + WS_ACT);
#ifdef PROBE_NORM2
        if (s == 0) { norm_rows_bf16((l == 0) ? PIN(0) : POUT, PIN(1) + (size_t)(l * 2 + 0) * DM, hn, gw, NGW, LANEV()); GRID_BAR(); }
        else if (s == 3) { norm_rows_bf16(POUT, PIN(5) + (size_t)l * DM, hn, gw, NGW, LANEV()); GRID_BAR(); }
        else if (s == 11) { norm_rows_bf16(POUT, PIN(1) + (size_t)(l * 2 + 1) * DM, hn, gw, NGW, LANEV()); GRID_BAR(); }
#endif
#ifdef PROBE_CMP2
        if (s == 8) { cmp_phase(lds, P, (const bf16_t*)(ws + WS_KC), (const bf16_t*)(ws + WS_VC), (bf16_t*)(ws + WS_OCMP), (unsigned long long*)(ws + WS_MASK), G, wave0); GRID_BAR(); }
#endif
#ifdef PROBE_SYNC2
        GRID_BAR();
#endif
        if (s == 0 || s == 3 || s == 11) continue;
        if (s == 5) {
            post_phase(P, (const float*)(ws + WS_TAB32), (const float*)(ws + WS_TAB64), PIN(7) + l * 256, PIN(9) + l * 128, PIN(17) + l * 24, PIN(13) + (size_t)(l * 2 + 0) * 2048, PIN(13) + (size_t)(l * 2 + 1) * 2048,
                       (bf16_t*)(ws + WS_CQN), (bf16_t*)(ws + WS_CKVN), (bf16_t*)(ws + WS_KMLA), (bf16_t*)(ws + WS_FLATK), (bf16_t*)(ws + WS_FLATV), (float*)(ws + WS_GATES), gw, NGW, LANEV());
        }
        else if (s == 8) {
#ifndef NO_CMP
 cmp_phase(lds, P, (const bf16_t*)(ws + WS_KC), (const bf16_t*)(ws + WS_VC), (bf16_t*)(ws + WS_OCMP), (unsigned long long*)(ws + WS_MASK), G, wave0);
#endif
 }
        else if (s == 9) {
#ifndef NO_ATTN
#ifdef PROBE_ATTN2
            attn_phase(lds, (int*)(ws + WS_CTL) + 16 + 8 * l, P, (const bf16_t*)(ws + WS_QM), (const bf16_t*)(ws + WS_KMLA), (const bf16_t*)(ws + WS_VMLA), (const unsigned long long*)(ws + WS_MASK),
                       (const bf16_t*)(ws + WS_OCMP), (const float*)(ws + WS_GATES), PIN(12) + l * 64, ((const float*)(ws + WS_CTL + 256))[2 * l], ((const float*)(ws + WS_CTL + 256))[2 * l + 1], hn, wave0);
            GRID_BAR();
#endif
            attn_phase(lds, (int*)(ws + WS_CTL) + 8 * l, P, (const bf16_t*)(ws + WS_QM), (const bf16_t*)(ws + WS_KMLA), (const bf16_t*)(ws + WS_VMLA), (const unsigned long long*)(ws + WS_MASK),
                       (const bf16_t*)(ws + WS_OCMP), (const float*)(ws + WS_GATES), PIN(12) + l * 64, ((const float*)(ws + WS_CTL + 256))[2 * l], ((const float*)(ws + WS_CTL + 256))[2 * l + 1], hn, wave0);
#endif
        }
        else if (s == 1) { gid0 = 0; ng = 1; f = 0; }
#ifdef PROBE_UP2
        if (s == 1 || s == 12) ng = 2;
#endif
        else if (s == 2) { gid0 = 1; ng = 1; f = 0; }
        else if (s == 4) { gid0 = 2; ng = 1; }
        else if (s == 6) { gid0 = 3; ng = 4; }
        else if (s == 7) { gid0 = 7; ng = 2; }
        else if (s == 10) { gid0 = 9; ng = 1; }
        else if (s == 12) { gid0 = 0; ng = 1; f = 1; }
        else { gid0 = 1; ng = 1; f = 1; }
#pragma nounroll
        for (int j = 0; j < ng; ++j) {
#ifdef PROBE_UP2
            const GemmDesc d = make_gemm((s == 1 || s == 12) ? 0 : gid0 + j, l, f, ws);
#else
            const GemmDesc d = make_gemm(gid0 + j, l, f, ws);
#endif
            pg8::Gemm g{d.A, d.Bt, d.M, d.N, d.K};
#ifdef PROBE_UP2
            EpiGen eg; eg.p = (const EpiP*)(ws + WS_CTL + 1024) + (l * 12 + ((s == 1) ? 0 : (s == 12) ? 10 : ((f && gid0 + j < 2) ? 10 + gid0 + j : gid0 + j)));
#else
            const EpiP* egp = (const EpiP*)(ws + WS_CTL + 1024) + (l * 12 + ((f && gid0 + j < 2) ? 10 + gid0 + j : gid0 + j));
#endif
            pg8::StaticOrder S; S.init(d.M, d.N, G, (int)((bid + d.rot) % G));
#ifndef NO_GEMM
#define RUN_GEMM_K(KK) { pg8::Gemm gk{d.A, d.Bt, d.M, d.N, KK}; EpiGenT<false> eg; eg.p = egp; pg8::gemm_phase<EpiGenT<false>, pg8::StaticOrder, true, true>(lds, gk, S, eg, wave0); }
            if (d.K == 1024) { pg8::Gemm gk{d.A, d.Bt, d.M, d.N, 1024}; EpiGenT<true> eg; eg.p = egp; pg8::gemm_phase<EpiGenT<true>, pg8::StaticOrder, true, true>(lds, gk, S, eg, wave0); }
            else if (d.K == 2816) { pg8::Gemm gk{d.A, d.Bt, d.M, d.N, 2816}; EpiGenT<true> eg; eg.p = egp; pg8::gemm_phase<EpiGenT<true>, pg8::StaticOrder, true, true>(lds, gk, S, eg, wave0); }
            else if (d.K == 256) RUN_GEMM_K(256)
            else if (d.K == 128) RUN_GEMM_K(128)
            else RUN_GEMM_K(2048)
#undef RUN_GEMM_K
            (void)g;
#endif
        }
        const int cfirst = (G > 96) ? 48 : 0;
        if (s == 6 && l == 0 && bid >= cfirst) {
            const int lane_ = LANEV();
            convert_layer(1, PIN(2), PIN(3), PIN(4), PIN(1), PIN(6), PIN(5), PIN(18), PIN(8), PIN(10), PIN(14), PIN(16), ws, (LAS float*)(lds + wave * 16384), (bid - cfirst) * 8 + wave, (G - cfirst) * 8, lane_);
        }
        GRID_BAR();
#ifdef PROBE_MASK
#if PROBE_MASK == 0x10000
        if (s == 5 && !rep_) { rep_ = 1; it -= 2; } else if (s == 5) rep_ = 0;
#elif PROBE_MASK == 0x20000
        if (it == 2 && !rep_) { rep_ = 1; --it; }
#else
        if (((PROBE_MASK >> s) & 1) && !rep_) { rep_ = 1; --it; } else rep_ = 0;
#endif
#endif
    }
    { unsigned char* ws = ws0; const int tid = make_tid(wave0), lane = tid & 63; norm_rows_f32_inplace(POUT, PIN(19), blockIdx.x * 8 + wave0, NGW, lane); }
}

extern "C" void kernel_launch(void* const* d_in, const int* in_sizes, int n_in, void* d_out, int out_size, void* d_ws, size_t ws_size, hipStream_t stream) {
    static int grid = 0;
    if (grid == 0) {
        if (n_in != 20 || out_size != MROWS * DM || ws_size < WS_END) {
            fprintf(stderr, "kernel_launch: unexpected shapes (n_in %d, out %d, ws %zu, need %zu)\n", n_in, out_size, ws_size, (size_t)WS_END); grid = -1; return; }
        int dev = 0, cus = 0, per_cu = 0;
        if (hipGetDevice(&dev) != hipSuccess || hipDeviceGetAttribute(&cus, hipDeviceAttributeMultiprocessorCount, dev) != hipSuccess) { grid = -1; return; }
        if (hipFuncSetAttribute((const void*)hymba_fwd, hipFuncAttributeMaxDynamicSharedMemorySize, LDS_BYTES) != hipSuccess) { fprintf(stderr, "kernel_launch: hipFuncSetAttribute failed\n"); grid = -1; return; }
        if (hipOccupancyMaxActiveBlocksPerMultiprocessor(&per_cu, (const void*)hymba_fwd, NTHR, LDS_BYTES) != hipSuccess || per_cu < 1) {
            fprintf(stderr, "kernel_launch: occupancy query gave %d\n", per_cu); per_cu = 1; }
        (void)hipGetLastError();
        grid = cus * 1;
        if (per_cu < 1) grid = -1;
    }
    if (grid < 0) return;
    KArgs a{};
    for (int i = 0; i < 20; ++i) a.in[i] = (const float*)d_in[i];
    a.out = (float*)d_out; a.ws = (unsigned char*)d_ws;
    void* args[] = {&a};
    hipError_t e = hipLaunchCooperativeKernel((const void*)hymba_fwd, dim3(grid), dim3(NTHR), args, LDS_BYTES, stream);
    if (e != hipSuccess) fprintf(stderr, "cooperative launch failed: %s (grid %d)\n", hipGetErrorString(e), grid);
}
```
